# Optimizing an MI355X kernel written in HIP

```python
import jax
import jax.numpy as jnp
from jax import lax
import numpy as np

D_MODEL = 1024
BATCH = 1
SEQ = 16384
DEPTH = 4

CTX_LEN = 256
GRID_W = 64
Q_BLOCK = 128
RET_CHUNK = 128
ROPE_BASE = 10000.0
NORM_EPS = 1e-6
N_MOD = 6

RET_HEADS = 4
RET_DK = 128
RET_DV = 256
RET_DECAY_START = 5.0
RET_BWD_OFFSET = 0.5

MLA_HEADS = 8
MLA_Q_RANK = 256
MLA_KV_RANK = 256
MLA_NOPE = 64
MLA_ROPE = 32
MLA_V = 128

GQA_HEADS = 8
GQA_KV_HEADS = 2
GQA_HD = 128

FFN_HIDDEN = ((8 * D_MODEL + 3 * 256 - 1) // (3 * 256)) * 256

RET_W = RET_HEADS * RET_DV
MLA_W = MLA_HEADS * MLA_V
GQA_W = GQA_HEADS * GQA_HD
N_BRANCH = 3

IN_SIZES = (
    RET_HEADS * RET_DK,
    RET_HEADS * RET_DK,
    RET_W,
    RET_W,
    MLA_Q_RANK,
    MLA_KV_RANK,
    MLA_ROPE,
    GQA_W,
    GQA_KV_HEADS * GQA_HD,
    GQA_KV_HEADS * GQA_HD,
    N_BRANCH * D_MODEL,
)
IN_DIM = sum(IN_SIZES)

kernel_name = 'hybrid_ret_mla_gqa_dit_trunk'


def rms_norm(x, g=None):
    xf = x.astype(jnp.float32)
    y = xf * lax.rsqrt(jnp.mean(xf * xf, axis=-1, keepdims=True) + NORM_EPS)
    if g is not None:
        y = y * g.astype(jnp.float32)
    return y.astype(x.dtype)


def modulate(x, shift, scale):
    return x * (1 + scale) + shift


def axis_angles(pos, dim):
    half = dim // 2
    inv_freq = ROPE_BASE ** (-jnp.arange(half, dtype=jnp.float32) / half)
    ang = pos.astype(jnp.float32)[:, None] * inv_freq[None, :]
    return jnp.cos(ang), jnp.sin(ang)


def rope_tables(rows, cols, dim):
    cr, sr = axis_angles(rows, dim // 2)
    cc, sc = axis_angles(cols, dim // 2)
    return (cr, sr, cc, sc)


def rotate_half(x, cos, sin):
    x1, x2 = jnp.split(x, 2, axis=-1)
    cos = cos[:, None, :]
    sin = sin[:, None, :]
    return jnp.concatenate([x1 * cos - x2 * sin, x2 * cos + x1 * sin], axis=-1)


def rope_2d(x, tabs):
    if tabs is None:
        return x
    cr, sr, cc, sc = tabs
    xr, xc = jnp.split(x.astype(jnp.float32), 2, axis=-1)
    out = jnp.concatenate([rotate_half(xr, cr, sr), rotate_half(xc, cc, sc)], axis=-1)
    return out.astype(x.dtype)


def retention_log_decay(offset):
    h = jnp.arange(RET_HEADS, dtype=jnp.float32)
    return jnp.log1p(-jnp.exp2(-(RET_DECAY_START + offset) - h))


def retention_scan(q, k, v, log_gamma, state0):
    B, T, H, dk = q.shape
    dv = v.shape[-1]
    C = RET_CHUNK
    n = T // C
    qc = q.astype(jnp.float32).reshape(B, n, C, H, dk)
    kc = k.astype(jnp.float32).reshape(B, n, C, H, dk)
    vc = v.astype(jnp.float32).reshape(B, n, C, H, dv)
    pos = jnp.arange(C, dtype=jnp.float32)
    diff = pos[:, None] - pos[None, :]
    lower = diff >= 0
    decay = jnp.where(lower[None],
                      jnp.exp(log_gamma[:, None, None] * jnp.where(lower, diff, 0.0)[None]),
                      0.0)
    scores = jnp.einsum('bnihd,bnjhd->bnhij', qc, kc) * decay
    inner = jnp.einsum('bnhij,bnjhe->bnihe', scores, vc)
    zeta = jnp.exp(log_gamma[:, None] * (C - 1 - pos)[None, :])
    upd = jnp.einsum('bnjhd,bnjhe,hj->nbhde', kc, vc, zeta)
    chunk_decay = jnp.exp(log_gamma * C)[None, :, None, None]

    def step(s, u):
        return chunk_decay * s + u, s

    s_final, s_prev = lax.scan(step, state0, upd)
    xi = jnp.exp(log_gamma[:, None] * (pos + 1)[None, :])
    cross = jnp.einsum('bnihd,nbhde,hi->bnihe', qc, s_prev, xi)
    return (inner + cross).reshape(B, T, H, dv), s_final


def retention_readout(y, g):
    B, T = y.shape[:2]
    y = rms_norm(y).reshape(B, T, RET_W)
    return (jax.nn.silu(g.astype(jnp.float32)) * y).astype(g.dtype)


def retention_branch(fl, fc, need_ctx):
    lg_f = retention_log_decay(0.0)
    lg_b = retention_log_decay(RET_BWD_OFFSET)
    B = fl['ret_q'].shape[0]
    zero = jnp.zeros((B, RET_HEADS, RET_DK, RET_DV), jnp.float32)
    rev = lambda a: a[:, ::-1]
    qc, kc, vc = fc['ret_q'], fc['ret_k'], fc['ret_v']
    q, k, v = fl['ret_q'], fl['ret_k'], fl['ret_v']
    yc_f, s_f = retention_scan(qc, kc, vc, lg_f, zero)
    yc_b, s_b = retention_scan(rev(qc), rev(kc), rev(vc), lg_b, zero)
    y_f, _ = retention_scan(q, k, v, lg_f, s_f)
    y_b, _ = retention_scan(rev(q), rev(k), rev(v), lg_b, s_b)
    y = retention_readout(y_f + rev(y_b), fl['ret_g'])
    yc = retention_readout(yc_f + rev(yc_b), fc['ret_g']) if need_ctx else None
    return y, yc


def mixer_features(p, g_mla_q, g_mla_kv, w_mla_qb, w_mla_kvb, g_gqa_q, g_gqa_k,
                   tabs_ret, tabs_mla, tabs_gqa):
    B, T, _ = p.shape
    split_at = np.cumsum(IN_SIZES)[:-1].tolist()
    (rq, rk, rv, rg, cq, ckv, kr, gq, gk, gv, gates) = jnp.split(p, split_at, axis=-1)
    f = {}
    f['ret_q'] = rope_2d(rq.reshape(B, T, RET_HEADS, RET_DK), tabs_ret)
    f['ret_k'] = rope_2d(rk.reshape(B, T, RET_HEADS, RET_DK), tabs_ret) * (RET_DK ** -0.5)
    f['ret_v'] = rv.reshape(B, T, RET_HEADS, RET_DV)
    f['ret_g'] = rg
    qh = (rms_norm(cq, g_mla_q) @ w_mla_qb).reshape(B, T, MLA_HEADS, MLA_NOPE + MLA_ROPE)
    q_nope, q_pe = jnp.split(qh, [MLA_NOPE], axis=-1)
    kvh = (rms_norm(ckv, g_mla_kv) @ w_mla_kvb).reshape(B, T, MLA_HEADS, MLA_NOPE + MLA_V)
    k_nope, f['mla_v'] = jnp.split(kvh, [MLA_NOPE], axis=-1)
    k_pe = jnp.broadcast_to(rope_2d(kr[:, :, None, :], tabs_mla), (B, T, MLA_HEADS, MLA_ROPE))
    f['mla_q'] = jnp.concatenate([q_nope, rope_2d(q_pe, tabs_mla)], axis=-1)
    f['mla_k'] = jnp.concatenate([k_nope, k_pe], axis=-1)
    f['gqa_q'] = rope_2d(rms_norm(gq.reshape(B, T, GQA_HEADS, GQA_HD), g_gqa_q), tabs_gqa)
    f['gqa_k'] = rope_2d(rms_norm(gk.reshape(B, T, GQA_KV_HEADS, GQA_HD), g_gqa_k), tabs_gqa)
    f['gqa_v'] = gv.reshape(B, T, GQA_KV_HEADS, GQA_HD)
    f['gates'] = gates.reshape(B, T, N_BRANCH, D_MODEL)
    return f


def block_attention(q, k, v, scale):
    B, L, Hk, G, d = q.shape
    e = v.shape[-1]
    nb = L // Q_BLOCK
    kf = k.astype(jnp.float32)
    vf = v.astype(jnp.float32)
    qb = jnp.moveaxis(q.reshape(B, nb, Q_BLOCK, Hk, G, d), 1, 0)

    def one_block(qblk):
        s = jnp.einsum('bqhgd,bshd->bhgqs', qblk.astype(jnp.float32), kf) * scale
        pr = jax.nn.softmax(s, axis=-1)
        return jnp.einsum('bhgqs,bshe->bqhge', pr, vf).astype(q.dtype)

    o = lax.map(one_block, qb)
    return jnp.moveaxis(o, 0, 1).reshape(B, L, Hk * G * e)


def merge_branches(y_ret, y_mla, y_gqa, gates, w_ret_o, w_mla_o, w_gqa_o, w_out):
    gs = jax.nn.sigmoid(gates)
    z = (gs[:, :, 0] * (y_ret @ w_ret_o)
         + gs[:, :, 1] * (y_mla @ w_mla_o)
         + gs[:, :, 2] * (y_gqa @ w_gqa_o))
    return z @ w_out


def token_mixer(h, hc, w_in, g_mla_q, g_mla_kv, w_mla_qb, w_mla_kvb, g_gqa_q, g_gqa_k,
                w_ret_o, w_mla_o, w_gqa_o, w_out, tabs_ret, tabs_mla, tabs_gqa, need_ctx):
    B, L = h.shape[:2]
    Cn = hc.shape[1]
    G = GQA_HEADS // GQA_KV_HEADS
    mla_scale = (MLA_NOPE + MLA_ROPE) ** -0.5
    gqa_scale = GQA_HD ** -0.5
    fl = mixer_features(h @ w_in, g_mla_q, g_mla_kv, w_mla_qb, w_mla_kvb, g_gqa_q, g_gqa_k,
                        tabs_ret, tabs_mla, tabs_gqa)
    fc = mixer_features(hc @ w_in, g_mla_q, g_mla_kv, w_mla_qb, w_mla_kvb, g_gqa_q, g_gqa_k,
                        None, None, None)
    y_ret, yc_ret = retention_branch(fl, fc, need_ctx)
    mla_k = jnp.concatenate([fc['mla_k'], fl['mla_k']], axis=1)
    mla_v = jnp.concatenate([fc['mla_v'], fl['mla_v']], axis=1)
    y_mla = block_attention(fl['mla_q'][:, :, :, None, :], mla_k, mla_v, mla_scale)
    gqa_k = jnp.concatenate([fc['gqa_k'], fl['gqa_k']], axis=1)
    gqa_v = jnp.concatenate([fc['gqa_v'], fl['gqa_v']], axis=1)
    y_gqa = block_attention(fl['gqa_q'].reshape(B, L, GQA_KV_HEADS, G, GQA_HD),
                            gqa_k, gqa_v, gqa_scale)
    y = merge_branches(y_ret, y_mla, y_gqa, fl['gates'], w_ret_o, w_mla_o, w_gqa_o, w_out)
    if not need_ctx:
        return y, None
    yc_mla = block_attention(fc['mla_q'][:, :, :, None, :], fc['mla_k'], fc['mla_v'], mla_scale)
    yc_gqa = block_attention(fc['gqa_q'].reshape(B, Cn, GQA_KV_HEADS, G, GQA_HD),
                             fc['gqa_k'], fc['gqa_v'], gqa_scale)
    yc = merge_branches(yc_ret, yc_mla, yc_gqa, fc['gates'], w_ret_o, w_mla_o, w_gqa_o, w_out)
    return y, yc


def swiglu(h, w_ffn_in, w_ffn_out):
    a, b = jnp.split(h @ w_ffn_in, 2, axis=-1)
    return (jax.nn.silu(a) * b) @ w_ffn_out


def setup_inputs(seed: int = 0) -> dict:
    key = jax.random.key(seed)
    ks = jax.random.split(key, 22)
    f32 = jnp.float32
    D = D_MODEL

    def normal(k, shape, s=1.0):
        return jax.random.normal(k, shape, f32) * s

    def dense(k, shape, fan_in, gain=1.0):
        return jax.random.normal(k, shape, f32) * (gain * fan_in ** -0.5)

    def norm_gain(k, shape):
        return 1.0 + 0.02 * jax.random.normal(k, shape, f32)

    return {
        'x': normal(ks[0], (BATCH, SEQ, D)),
        'c': normal(ks[1], (BATCH, D)),
        'ctx': normal(ks[2], (BATCH, CTX_LEN, D)),
        'c_ctx': normal(ks[3], (D,)),
        'w_mod': dense(ks[4], (DEPTH, D, N_MOD * D), D, 0.5),
        'b_mod': normal(ks[5], (DEPTH, N_MOD * D), 0.02),
        'g_mix': norm_gain(ks[6], (DEPTH, D)),
        'w_in': dense(ks[7], (DEPTH, D, IN_DIM), D),
        'g_mla_q': norm_gain(ks[8], (DEPTH, MLA_Q_RANK)),
        'g_mla_kv': norm_gain(ks[9], (DEPTH, MLA_KV_RANK)),
        'w_mla_qb': dense(ks[10], (DEPTH, MLA_Q_RANK, MLA_HEADS * (MLA_NOPE + MLA_ROPE)), MLA_Q_RANK),
        'w_mla_kvb': dense(ks[11], (DEPTH, MLA_KV_RANK, MLA_HEADS * (MLA_NOPE + MLA_V)), MLA_KV_RANK),
        'g_gqa_q': norm_gain(ks[12], (DEPTH, GQA_HD)),
        'g_gqa_k': norm_gain(ks[13], (DEPTH, GQA_HD)),
        'w_ret_o': dense(ks[14], (DEPTH, RET_W, D), RET_W),
        'w_mla_o': dense(ks[15], (DEPTH, MLA_W, D), MLA_W),
        'w_gqa_o': dense(ks[16], (DEPTH, GQA_W, D), GQA_W),
        'w_out': dense(ks[17], (DEPTH, D, D), D),
        'g_ffn': norm_gain(ks[18], (DEPTH, D)),
        'w_ffn_in': dense(ks[19], (DEPTH, D, 2 * FFN_HIDDEN), D),
        'w_ffn_out': dense(ks[20], (DEPTH, FFN_HIDDEN, D), FFN_HIDDEN),
        'g_final': norm_gain(ks[21], (D,)),
    }


def reference(x, c, ctx, c_ctx, w_mod, b_mod, g_mix, w_in, g_mla_q, g_mla_kv, w_mla_qb,
              w_mla_kvb, g_gqa_q, g_gqa_k, w_ret_o, w_mla_o, w_gqa_o, w_out, g_ffn,
              w_ffn_in, w_ffn_out, g_final):
    B, L, D = x.shape
    ROWS = L // GRID_W
    rows = jnp.repeat(jnp.arange(ROWS, dtype=jnp.int32), GRID_W)
    cols = jnp.arange(ROWS * GRID_W, dtype=jnp.int32) % GRID_W
    tabs_ret = rope_tables(rows, cols, RET_DK)
    tabs_mla = rope_tables(rows, cols, MLA_ROPE)
    tabs_gqa = rope_tables(rows, cols, GQA_HD)
    sc = jax.nn.silu(c)
    scc = jax.nn.silu(c_ctx)
    xc = ctx
    for l in range(DEPTH):
        need_ctx = l < DEPTH - 1
        mod = (sc @ w_mod[l] + b_mod[l]).reshape(B, 1, N_MOD, D)
        modc = (scc @ w_mod[l] + b_mod[l]).reshape(1, 1, N_MOD, D)
        h = modulate(rms_norm(x, g_mix[l]), mod[:, :, 0], mod[:, :, 1])
        hc = modulate(rms_norm(xc, g_mix[l]), modc[:, :, 0], modc[:, :, 1])
        y, yc = token_mixer(h, hc, w_in[l], g_mla_q[l], g_mla_kv[l], w_mla_qb[l], w_mla_kvb[l],
                            g_gqa_q[l], g_gqa_k[l], w_ret_o[l], w_mla_o[l], w_gqa_o[l], w_out[l],
                            tabs_ret, tabs_mla, tabs_gqa, need_ctx)
        x = x + mod[:, :, 2] * y
        h2 = modulate(rms_norm(x, g_ffn[l]), mod[:, :, 3], mod[:, :, 4])
        x = x + mod[:, :, 5] * swiglu(h2, w_ffn_in[l], w_ffn_out[l])
        if need_ctx:
            xc = xc + modc[:, :, 2] * yc
            hc2 = modulate(rms_norm(xc, g_ffn[l]), modc[:, :, 3], modc[:, :, 4])
            xc = xc + modc[:, :, 5] * swiglu(hc2, w_ffn_in[l], w_ffn_out[l])
    return rms_norm(x, g_final)
```

```cpp
#include <hip/hip_runtime.h>
#include <hip/hip_cooperative_groups.h>
#include <cmath>
#include <cstdio>
#include <cstdint>
namespace cg = cooperative_groups;

#define DI __device__ __forceinline__
typedef unsigned short bf16_t;
using bf16x8 = __attribute__((ext_vector_type(8))) short;
using s16x4  = __attribute__((ext_vector_type(4))) short;
using f32x16 = __attribute__((ext_vector_type(16))) float;
using f32x4  = __attribute__((ext_vector_type(4))) float;
using u32x4  = __attribute__((ext_vector_type(4))) unsigned;
using u32x2  = __attribute__((ext_vector_type(2))) unsigned;

constexpr int DM = 1024, SEQL = 16384, CTXN = 256, MR = SEQL + CTXN, DEPTH = 4;
constexpr int PW = 5376;
constexpr int C_RQ = 0, C_RK = 512, C_RV = 1024, C_RG = 2048, C_CQ = 3072, C_CKV = 3328, C_KR = 3584, C_GQ = 3616, C_GK = 4640, C_GV = 4896;
constexpr int NMAIN = 5152, NINROWS = 8448, GATE_ROW0 = 5376;
constexpr int FH = 2816, NCH = 130;
constexpr int LDS_BYTES = 163840;

constexpr size_t SZ_WIN = (size_t)NINROWS * 1024 * 2, SZ_QB = 768 * 256 * 2, SZ_KVB = 1536 * 256 * 2, SZ_SQ = 1024 * 1024 * 2,
                 SZ_FI = (size_t)5632 * 1024 * 2, SZ_FO = (size_t)1024 * FH * 2;
constexpr size_t O_WIN = 0, O_QB = O_WIN + SZ_WIN, O_KVB = O_QB + SZ_QB, O_RO = O_KVB + SZ_KVB, O_MO = O_RO + SZ_SQ, O_GO = O_MO + SZ_SQ,
                 O_WO = O_GO + SZ_SQ, O_FI = O_WO + SZ_SQ, O_FO = O_FI + SZ_FI, O_WEND = O_FO + SZ_FO;
constexpr size_t O_X = O_WEND, SZ_X = (size_t)MR * 1024 * 4;
constexpr size_t O_PM = O_X + SZ_X, SZ_PM = (size_t)MR * PW * 2;
constexpr size_t O_CB = O_PM + SZ_PM;
constexpr size_t SZ_H = (size_t)MR * 1024 * 2, SZ_S = (size_t)NCH * 2 * 4 * 256 * 128 * 2, SZ_MQ = (size_t)MR * 768 * 2, SZ_MKV = (size_t)MR * 1536 * 2;
constexpr size_t O_H = O_CB, O_S = O_H + SZ_H, O_MQ = O_S + SZ_S, O_MKV = O_MQ + SZ_MQ, O_CBEND = O_MKV + SZ_MKV;
constexpr size_t O_ZF = O_CB, SZ_ZF = (size_t)MR * 1024 * 4, O_GATES = O_ZF + SZ_ZF, SZ_GATES = (size_t)MR * 3072 * 2;
static_assert(O_GATES + SZ_GATES <= O_CBEND, "gates alias");
constexpr size_t O_MODS = O_CBEND, SZ_MODS = (size_t)DEPTH * 2 * 6144 * 4;
constexpr size_t O_T128 = O_MODS + SZ_MODS, SZ_T128 = 256 * 32 * 2 * 4, O_T32 = O_T128 + SZ_T128, SZ_T32 = 256 * 8 * 2 * 4, WS_END = O_T32 + SZ_T32;
constexpr size_t O_ACT = O_PM;
static_assert((size_t)MR * FH * 2 <= SZ_PM, "act alias");

struct Params {
  const float *x, *c, *ctx, *c_ctx, *w_mod, *b_mod, *g_mix, *w_in, *g_mla_q, *g_mla_kv, *w_mla_qb, *w_mla_kvb, *g_gqa_q, *g_gqa_k,
              *w_ret_o, *w_mla_o, *w_gqa_o, *w_out, *g_ffn, *w_ffn_in, *w_ffn_out, *g_final;
  float* out; unsigned char* ws;
  float lg2[8];
};

extern __shared__ __attribute__((aligned(16))) char smem[];
__device__ __forceinline__ const Params& kargs() { int z = 0; asm volatile("" : "+s"(z)); return *(const Params*)((const char*)__builtin_amdgcn_kernarg_segment_ptr() + z); }

DI float bf2f(bf16_t b) { return __uint_as_float(((unsigned)b) << 16); }
typedef __bf16 bf16v2_t __attribute__((ext_vector_type(2)));
typedef float f32v2_t __attribute__((ext_vector_type(2)));
DI unsigned cvtpk(float lo, float hi) { f32v2_t v = {lo, hi}; bf16v2_t b = __builtin_convertvector(v, bf16v2_t); return __builtin_bit_cast(unsigned, b); }
DI bf16_t f2bf(float x) { return (bf16_t)(cvtpk(x, 0.f) & 0xffffu); }
DI float wsum(float v) { for (int o = 32; o > 0; o >>= 1) v += __shfl_xor(v, o); return v; }
DI int crow(int r, int hi) { return (r & 3) + 8 * (r >> 2) + 4 * hi; }
DI bf16x8 ld8(const bf16_t* p) { return *reinterpret_cast<const bf16x8*>(p); }
DI float sigm(float v) { return 1.f / (1.f + __expf(-v)); }
DI int otid() { int t = threadIdx.x; asm volatile("" : "+v"(t)); return t; }
DI unsigned char* opq(unsigned char* q) { int z = 0; asm volatile("" : "+s"(z)); return q + z; }
#define SBAR() __builtin_amdgcn_sched_barrier(0)
#define MFMA32(a, b, c) __builtin_amdgcn_mfma_f32_32x32x16_bf16((a), (b), (c), 0, 0, 0)

#define LAS __attribute__((address_space(3)))
constexpr int BK = 64, HALF = 128, HTB = HALF * BK * 2;
DI int lds_byte(int r, int c) { const int st = (r >> 4) * 2 + (c >> 5), rr = r & 15, cc = c & 31, ob = rr * 64 + cc * 2; return st * 1024 + (ob ^ (((ob >> 9) & 1) << 5)); }
DI void stage_rc(int b, int& R, int& C) { const int st = b / 1024, sb = b % 1024, swz = sb ^ (((sb >> 9) & 1) << 5); R = (st >> 1) * 16 + swz / 64; C = (st & 1) * 32 + (swz % 64) / 2; }
typedef f32x4 acc_t[2][2][4][2];

DI bool tile_map(int idx, int nM, int nN, int& pm, int& pn) {
  const int nwg = nM * nN; if (idx >= nwg) return false;
  int wgid = idx; { const int q = nwg / 8, r = nwg % 8, xcd = wgid % 8, off = wgid / 8; wgid = (xcd < r ? xcd * (q + 1) : r * (q + 1) + (xcd - r) * q) + off; }
  const int nig = 8 * nN, gid = wgid / nig, fm = gid * 8, gsz = (nM - fm) < 8 ? (nM - fm) : 8;
  pm = fm + ((wgid % nig) % gsz); pn = (wgid % nig) / gsz; return true;
}
struct Unit { int pm, pn, b; };
template <bool MERGE>
DI bool unit_next(int nM, int nN, int ui, Unit& u) {
  const int ti = MERGE ? ui / 3 : ui; u.b = MERGE ? ui - ti * 3 : 0;
  return tile_map(ti * (int)gridDim.x + (int)blockIdx.x, nM, nN, u.pm, u.pn);
}
template <bool MERGE>
DI const char* unit_A(const bf16_t* A, int lda, const Unit& u) { const int off = MERGE ? (u.b == 0 ? C_RG : (u.b == 1 ? C_RQ : C_GQ)) : 0; return (const char*)(A + off) + (size_t)u.pm * 512 * lda; }
template <bool MERGE>
DI const char* unit_B(const bf16_t* B, int ldb, const Unit& u) { return (const char*)(B + (MERGE ? (size_t)u.b * 1024 * 1024 : 0)) + (size_t)u.pn * 512 * ldb; }

template <bool MERGE, class Epi>
DI void gemm_phase(const bf16_t* __restrict__ gA, const int lda, const bf16_t* __restrict__ gB, const int ldb, const int K, const int nM, const int nN, const Epi& E) {
  LAS unsigned char* lds = (LAS unsigned char*)smem;
  const int tid = otid(), wid = __builtin_amdgcn_readfirstlane(tid >> 6), lane = tid & 63, wr = wid >> 2, wc = wid & 3, fr = lane & 15, fq = lane >> 4;
  const int nt = K / BK;
  unsigned voffA[2], voffB[2];
#pragma unroll
  for (int i = 0; i < 2; ++i) { int R, C; stage_rc(tid * 16 + i * 8192, R, C); voffA[i] = (unsigned)(R * lda + C) * 2u; voffB[i] = (unsigned)(R * ldb + C) * 2u; }
  const size_t kstep = (size_t)(BK * 2);
  const size_t hstepA = (size_t)HALF * lda * 2, hstepB = (size_t)HALF * ldb * 2;
  const unsigned ldsw = (unsigned)wid * 1024u;
  const int aoff = lds_byte(wr * 64 + fr, fq * 8), boff = lds_byte(wc * 32 + fr, fq * 8);
#define PG8_SA(b, h) (((b) * 2 + (h)) * HTB)
#define PG8_SB(b, h) ((4 + (b) * 2 + (h)) * HTB)
#define PG8_STAGE(bufoff, gbase, voff) do { _Pragma("unroll") for (int _i = 0; _i < 2; ++_i) \
    __builtin_amdgcn_global_load_lds((const unsigned*)((const char*)(gbase) + (voff)[_i]), (LAS unsigned*)(lds + (bufoff) + ldsw + _i * 8192), 16, 0, 0); } while (0)
#define PG8_LDA(dst, b, h) do { _Pragma("unroll") for (int m = 0; m < 4; ++m) _Pragma("unroll") for (int k = 0; k < 2; ++k) dst[m][k] = *(const LAS bf16x8*)(lds + PG8_SA(b, h) + aoff + m * 2048 + k * 1024); } while (0)
#define PG8_LDB(dst, b, h) do { _Pragma("unroll") for (int n = 0; n < 2; ++n) _Pragma("unroll") for (int k = 0; k < 2; ++k) dst[n][k] = *(const LAS bf16x8*)(lds + PG8_SB(b, h) + boff + n * 2048 + k * 1024); } while (0)
#define PG8_MMA(ai, bj, At, Bt) do { __builtin_amdgcn_s_setprio(1); _Pragma("unroll") for (int m = 0; m < 4; ++m) _Pragma("unroll") for (int n = 0; n < 2; ++n) _Pragma("unroll") for (int k = 0; k < 2; ++k) \
    acc[ai][bj][m][n] = __builtin_amdgcn_mfma_f32_16x16x32_bf16(Bt[n][k], At[m][k], acc[ai][bj][m][n], 0, 0, 0); __builtin_amdgcn_s_setprio(0); } while (0)
#define PG8_WAIT_V(n) asm volatile("s_waitcnt vmcnt(" #n ")" ::: "memory")
#define PG8_WAIT_L(n) asm volatile("s_waitcnt lgkmcnt(" #n ")" ::: "memory")
#define PG8_BAR __builtin_amdgcn_s_barrier()
#define PG8_SCHED __builtin_amdgcn_sched_barrier(0)
  Unit cur, nxt; int ui = 0;
  if (!unit_next<MERGE>(nM, nN, 0, cur)) return;
  f32x4 acc[2][2][4][2];
#pragma unroll
  for (int a = 0; a < 2; ++a)
#pragma unroll
    for (int b = 0; b < 2; ++b)
#pragma unroll
      for (int m = 0; m < 4; ++m)
#pragma unroll
        for (int n = 0; n < 2; ++n) acc[a][b][m][n] = (f32x4){0.f, 0.f, 0.f, 0.f};
  bf16x8 At[4][2], B0[2][2], B1[2][2];
  const char* cA = unit_A<MERGE>(gA, lda, cur); const char* cB = unit_B<MERGE>(gB, ldb, cur);
  PG8_STAGE(PG8_SB(0, 0), cB, voffB); PG8_STAGE(PG8_SA(0, 0), cA, voffA); PG8_STAGE(PG8_SB(0, 1), cB + hstepB, voffB); PG8_STAGE(PG8_SA(0, 1), cA + hstepA, voffA);
  if (wr == 1) PG8_BAR;
  PG8_WAIT_V(4); PG8_BAR;
  PG8_STAGE(PG8_SB(1, 0), cB + kstep, voffB); PG8_STAGE(PG8_SA(1, 0), cA + kstep, voffA); PG8_STAGE(PG8_SB(1, 1), cB + hstepB + kstep, voffB);
  PG8_WAIT_V(6); PG8_BAR;
  for (;;) {
    const bool has_next = unit_next<MERGE>(nM, nN, ui + 1, nxt);
    const char* nA = has_next ? unit_A<MERGE>(gA, lda, nxt) : cA; const char* nB = has_next ? unit_B<MERGE>(gB, ldb, nxt) : cB;
#pragma unroll 1
    for (int t = 0; t < nt; t += 2) {
      const bool last = (t == nt - 2);
      const char* a1 = cA + (size_t)(t + 1) * kstep;
      const char* a2 = last ? nA : cA + (size_t)(t + 2) * kstep; const char* b2 = last ? nB : cB + (size_t)(t + 2) * kstep;
      const char* a3 = a2 + kstep; const char* b3 = b2 + kstep;
      PG8_LDB(B0, 0, 0); PG8_SCHED; PG8_LDA(At, 0, 0); PG8_STAGE(PG8_SA(1, 1), a1 + hstepA, voffA);
      PG8_WAIT_L(8); PG8_BAR; PG8_WAIT_L(0); PG8_MMA(0, 0, At, B0); PG8_BAR; PG8_SCHED;
      PG8_LDB(B1, 0, 1); PG8_STAGE(PG8_SB(0, 0), b2, voffB);
      PG8_BAR; PG8_WAIT_L(0); PG8_MMA(0, 1, At, B1); PG8_BAR;
      PG8_LDA(At, 0, 1); PG8_STAGE(PG8_SA(0, 0), a2, voffA);
      PG8_BAR; PG8_WAIT_L(0); PG8_MMA(1, 0, At, B0); PG8_BAR; PG8_SCHED;
      PG8_STAGE(PG8_SB(0, 1), b2 + hstepB, voffB);
      PG8_WAIT_V(6); PG8_BAR; PG8_MMA(1, 1, At, B1); PG8_BAR;
      PG8_LDB(B0, 1, 0); PG8_SCHED; PG8_LDA(At, 1, 0); PG8_STAGE(PG8_SA(0, 1), a2 + hstepA, voffA);
      PG8_WAIT_L(8); PG8_BAR; PG8_WAIT_L(0); PG8_MMA(0, 0, At, B0); PG8_BAR; PG8_SCHED;
      PG8_LDB(B1, 1, 1); PG8_STAGE(PG8_SB(1, 0), b3, voffB);
      PG8_BAR; PG8_WAIT_L(0); PG8_MMA(0, 1, At, B1); PG8_BAR;
      PG8_LDA(At, 1, 1); PG8_STAGE(PG8_SA(1, 0), a3, voffA);
      PG8_BAR; PG8_WAIT_L(0); PG8_MMA(1, 0, At, B0); PG8_BAR; PG8_SCHED;
      PG8_STAGE(PG8_SB(1, 1), b3 + hstepB, voffB);
      PG8_WAIT_V(6); PG8_BAR; PG8_MMA(1, 1, At, B1); PG8_BAR;
    }
    E(acc, cur.pm, cur.pn, cur.b, wr, wc, fr, fq);
    if (!has_next) break;
#pragma unroll
    for (int a = 0; a < 2; ++a)
#pragma unroll
      for (int b = 0; b < 2; ++b)
#pragma unroll
        for (int m = 0; m < 4; ++m)
#pragma unroll
          for (int n = 0; n < 2; ++n) acc[a][b][m][n] = (f32x4){0.f, 0.f, 0.f, 0.f};
    cur = nxt; cA = nA; cB = nB; ++ui;
  }
  PG8_WAIT_V(0);
  if (wr == 0) PG8_BAR;
  PG8_BAR;
#undef PG8_SA
#undef PG8_SB
#undef PG8_STAGE
#undef PG8_LDA
#undef PG8_LDB
#undef PG8_MMA
}

struct EpiStore { bf16_t* C; long ldc; int sig;
  DI void operator()(const acc_t& acc, int pm, int pn, int ub, int wr, int wc, int fr, int fq) const {
#pragma unroll
    for (int ai = 0; ai < 2; ++ai)
#pragma unroll
      for (int m = 0; m < 4; ++m) { bf16_t* rp = C + (long)(pm * 256 + ai * 128 + wr * 64 + m * 16 + fr) * ldc + pn * 256 + wc * 32 + fq * 4;
#pragma unroll
        for (int bj = 0; bj < 2; ++bj)
#pragma unroll
          for (int n = 0; n < 2; ++n) { f32x4 v = acc[ai][bj][m][n];
            if (sig) { v[0] = sigm(v[0]); v[1] = sigm(v[1]); v[2] = sigm(v[2]); v[3] = sigm(v[3]); }
            u32x2 o = {cvtpk(v[0], v[1]), cvtpk(v[2], v[3])}; *(u32x2*)(rp + bj * 128 + n * 16) = o; } } } };
struct EpiMerge { float* zf; const bf16_t* gates; bf16_t* zb; long ldz;
  DI void operator()(const acc_t& acc, int pm, int pn, int b, int wr, int wc, int fr, int fq) const {
#pragma unroll
    for (int ai = 0; ai < 2; ++ai)
#pragma unroll
      for (int m = 0; m < 4; ++m) { const long row = pm * 256 + ai * 128 + wr * 64 + m * 16 + fr; const int c0 = pn * 256 + wc * 32 + fq * 4;
#pragma unroll
        for (int bj = 0; bj < 2; ++bj)
#pragma unroll
          for (int n = 0; n < 2; ++n) { const int col = c0 + bj * 128 + n * 16; const f32x4 v = acc[ai][bj][m][n];
            const u32x2 g = *(const u32x2*)(gates + row * 3072 + b * 1024 + col);
            f32x4 z = {v[0] * __uint_as_float(g[0] << 16), v[1] * __uint_as_float(g[0] & 0xffff0000u), v[2] * __uint_as_float(g[1] << 16), v[3] * __uint_as_float(g[1] & 0xffff0000u)};
            float* zp = zf + row * 1024 + col;
            if (b) z += *(const f32x4*)zp;
            if (b == 2) { u32x2 o = {cvtpk(z[0], z[1]), cvtpk(z[2], z[3])}; *(u32x2*)(zb + row * ldz + col) = o; } else *(f32x4*)zp = z; } } } };
struct EpiResid { float* X; const float* mods; int mi;
  DI void operator()(const acc_t& acc, int pm, int pn, int ub, int wr, int wc, int fr, int fq) const {
    const float* mv = mods + (pm == 0 ? 6144 : 0) + mi * 1024;
#pragma unroll
    for (int ai = 0; ai < 2; ++ai)
#pragma unroll
      for (int m = 0; m < 4; ++m) { const long row = pm * 256 + ai * 128 + wr * 64 + m * 16 + fr; const int c0 = pn * 256 + wc * 32 + fq * 4;
#pragma unroll
        for (int bj = 0; bj < 2; ++bj)
#pragma unroll
          for (int n = 0; n < 2; ++n) { const int col = c0 + bj * 128 + n * 16; float* xp = X + row * 1024 + col;
            const f32x4 g = *(const f32x4*)(mv + col); *(f32x4*)xp = *(const f32x4*)xp + g * acc[ai][bj][m][n]; } } } };
struct EpiSwiglu { bf16_t* act;
  DI void operator()(const acc_t& acc, int pm, int pn, int ub, int wr, int wc, int fr, int fq) const {
#pragma unroll
    for (int ai = 0; ai < 2; ++ai)
#pragma unroll
      for (int m = 0; m < 4; ++m) { bf16_t* rp = act + (long)(pm * 256 + ai * 128 + wr * 64 + m * 16 + fr) * FH + pn * 128 + wc * 32 + fq * 4;
#pragma unroll
        for (int n = 0; n < 2; ++n) { const f32x4 a = acc[ai][0][m][n], b = acc[ai][1][m][n];
          u32x2 o = {cvtpk(a[0] * sigm(a[0]) * b[0], a[1] * sigm(a[1]) * b[1]), cvtpk(a[2] * sigm(a[2]) * b[2], a[3] * sigm(a[3]) * b[3])};
          *(u32x2*)(rp + n * 16) = o; } } } };

constexpr int QBLK = 32, KVBLK = 64;
constexpr size_t SHM_V = KVBLK * 128 * 2, SHM_K = KVBLK * 128 * 2;
#define KSWZ(row, colB) ((row) * 256 + ((colB) ^ (((row) & 7) << 4)))

DI void partialSM(f32x16& p0, f32x16& p1, float& m_reg, float& mn, float& alpha, const float C, const float thr) {
  float pmax = p0[0];
#pragma unroll
  for (int r = 1; r < 16; ++r) pmax = fmaxf(pmax, p0[r]);
#pragma unroll
  for (int r = 0; r < 16; ++r) pmax = fmaxf(pmax, p1[r]);
  { auto rr = __builtin_amdgcn_permlane32_swap(__float_as_uint(pmax), __float_as_uint(pmax), false, false);
    pmax = fmaxf(__uint_as_float(rr[0]), __uint_as_float(rr[1])); }
  if (__builtin_expect(__all(pmax - m_reg <= thr), 1)) { mn = m_reg; alpha = 1.f; }
  else { mn = fmaxf(m_reg, pmax); alpha = __builtin_amdgcn_exp2f((m_reg - mn) * C); m_reg = mn; }
  const float mnC = -mn * C;
#pragma unroll
  for (int r = 0; r < 16; ++r) p0[r] = fmaf(p0[r], C, mnC);
#pragma unroll
  for (int r = 0; r < 16; ++r) p1[r] = fmaf(p1[r], C, mnC);
#pragma unroll
  for (int r = 0; r < 16; ++r) p0[r] = __builtin_amdgcn_exp2f(p0[r]);
}
DI void finishSM(f32x16& p0, f32x16& p1, float alpha, float& l_reg, bf16x8& pa0, bf16x8& pa1, bf16x8& pa2, bf16x8& pa3) {
#pragma unroll
  for (int r = 0; r < 16; ++r) p1[r] = __builtin_amdgcn_exp2f(p1[r]);
  float ps = 0;
#pragma unroll
  for (int r = 0; r < 16; ++r) ps += p0[r];
#pragma unroll
  for (int r = 0; r < 16; ++r) ps += p1[r];
  { auto rr = __builtin_amdgcn_permlane32_swap(__float_as_uint(ps), __float_as_uint(ps), false, false);
    ps = __uint_as_float(rr[0]) + __uint_as_float(rr[1]); }
  l_reg = l_reg * alpha + ps;
#define PK4(P, BASE, OUT) do { unsigned a0 = cvtpk(P[BASE + 0], P[BASE + 1]), a1 = cvtpk(P[BASE + 2], P[BASE + 3]);   \
    unsigned b0 = cvtpk(P[BASE + 4], P[BASE + 5]), b1 = cvtpk(P[BASE + 6], P[BASE + 7]);                              \
    auto r0 = __builtin_amdgcn_permlane32_swap(a0, b0, false, false); auto r1 = __builtin_amdgcn_permlane32_swap(a1, b1, false, false); \
    u32x4 w = {r0[0], r1[0], r0[1], r1[1]}; OUT = *reinterpret_cast<bf16x8*>(&w); } while (0)
  PK4(p0, 0, pa0); PK4(p0, 8, pa1); PK4(p1, 0, pa2); PK4(p1, 8, pa3);
#undef PK4
}
template <int NDK>
DI void qkt(f32x16& p0, f32x16& p1, const char* Ks, const bf16x8* qr, int r32, int hi) {
  p0 = f32x16{}; p1 = f32x16{};
#pragma unroll
  for (int d0 = 0; d0 < NDK; ++d0) { const int cb = (d0 * 16 + hi * 8) * 2;
    bf16x8 b0 = *reinterpret_cast<const bf16x8*>(Ks + KSWZ(r32, cb));
    bf16x8 b1 = *reinterpret_cast<const bf16x8*>(Ks + KSWZ(32 + r32, cb));
    p0 = MFMA32(b0, qr[d0], p0);
    p1 = MFMA32(b1, qr[d0], p1); }
}
DI int v_st(int k, int c) { const int kk = (k & ~0xC) | ((k & 4) << 1) | ((k & 8) >> 1); return ((kk >> 3) * 4 + (c >> 5)) * 512 + ((kk & 7) * 32 + (c & 31)) * 2; }
DI int v_rd_base(int lane) { return ((lane & 3) << 3) | (((lane >> 2) & 3) << 6) | (((lane >> 4) & 1) << 5) | (((lane >> 5) & 1) << 8); }
constexpr int v_rd_off(int d0, int ks, int half) { return d0 * 512 + ks * 4096 + half * 2048; }
template <int OFF> DI s16x4 tr_read(int vb) {
  s16x4 r; asm volatile("ds_read_b64_tr_b16 %0, %1 offset:%2" : "=&v"(r) : "v"(vb), "i"(OFF) : "memory"); return r;
}
template <int D0> DI void pv_one(f32x16& od, int vb, bf16x8 pa0, bf16x8 pa1, bf16x8 pa2, bf16x8 pa3) {
  const s16x4 l0 = tr_read<v_rd_off(D0, 0, 0)>(vb), h0 = tr_read<v_rd_off(D0, 0, 1)>(vb), l1 = tr_read<v_rd_off(D0, 1, 0)>(vb), h1 = tr_read<v_rd_off(D0, 1, 1)>(vb);
  const s16x4 l2 = tr_read<v_rd_off(D0, 2, 0)>(vb), h2 = tr_read<v_rd_off(D0, 2, 1)>(vb), l3 = tr_read<v_rd_off(D0, 3, 0)>(vb), h3 = tr_read<v_rd_off(D0, 3, 1)>(vb);
  asm volatile("s_waitcnt lgkmcnt(0)" ::: "memory"); SBAR();
#define PK(L, H) (bf16x8){L[0], L[1], L[2], L[3], H[0], H[1], H[2], H[3]}
  od = MFMA32(pa0, PK(l0, h0), od);
  od = MFMA32(pa1, PK(l1, h1), od);
  od = MFMA32(pa2, PK(l2, h2), od);
  od = MFMA32(pa3, PK(l3, h3), od);
#undef PK
}
DI void pv_d0(f32x16* o, int vb, bf16x8 pa0, bf16x8 pa1, bf16x8 pa2, bf16x8 pa3) {
  pv_one<0>(o[0], vb, pa0, pa1, pa2, pa3); pv_one<1>(o[1], vb, pa0, pa1, pa2, pa3); pv_one<2>(o[2], vb, pa0, pa1, pa2, pa3); pv_one<3>(o[3], vb, pa0, pa1, pa2, pa3);
}

template <int NDK>
DI void attn_item(const bf16_t* __restrict__ Qb, long ldq, const bf16_t* __restrict__ K0, long ldk0, const bf16_t* __restrict__ K1, long ldk1,
                  const bf16_t* __restrict__ Vh, long ldv, bf16_t* __restrict__ Ob, long ldo, int seq, const float C, const float thr) {
  char* lds = smem;
  __syncthreads();
  const int tid = otid(), wid = tid >> 6, lane = tid & 63, r32 = lane & 31, hi = lane >> 5;
  char* V_lds = lds; char* K_lds = lds + 2 * SHM_V;
  float* wsb = (float*)(lds + 2 * SHM_V + 2 * SHM_K) + wid * 64; float* li_l = wsb; float* al_l = wsb + 32;
  float m_reg = -1e30f, l_reg = 0; f32x16 o[4] = {}; bf16x8 qr[NDK];
  const bf16_t* Qw = Qb + (long)(wid * QBLK + r32) * ldq + hi * 8;
#pragma unroll
  for (int d0 = 0; d0 < NDK; ++d0) qr[d0] = ld8(Qw + d0 * 16);
  const int sr = tid >> 4, sc = (tid & 15) * 8, vst0 = v_st(sr, sc), vst1 = v_st(32 + sr, sc);
  const bf16_t* kp; long kld;
  if (NDK == 8 || sc < 64) { kp = K0 + sc; kld = ldk0; } else { kp = K1 + ((sc - 64) & 31); kld = ldk1; }
  const bf16_t* vp = Vh + sc;
  const int vb0 = (int)(uintptr_t)V_lds + v_rd_base(lane);
  struct { bf16x8 vs0, vs1, ks0, ks1; } sr_[2];
#define SLOAD(i, k0) do { sr_[i].vs0 = ld8(vp + (long)((k0) + sr) * ldv); sr_[i].vs1 = ld8(vp + (long)((k0) + 32 + sr) * ldv); \
    sr_[i].ks0 = ld8(kp + (long)((k0) + sr) * kld); sr_[i].ks1 = ld8(kp + (long)((k0) + 32 + sr) * kld); } while (0)
#define SWRITE(b, i) do { *(bf16x8*)(V_lds + (b) * SHM_V + vst0) = sr_[i].vs0;          \
    *(bf16x8*)(V_lds + (b) * SHM_V + vst1) = sr_[i].vs1; int kc = sc * 2;               \
    *(bf16x8*)(K_lds + (b) * SHM_K + KSWZ(sr, kc)) = sr_[i].ks0;                       \
    *(bf16x8*)(K_lds + (b) * SHM_K + KSWZ(32 + sr, kc)) = sr_[i].ks1; } while (0)
#define SWAIT() asm volatile("s_waitcnt vmcnt(4)" ::: "memory")
#define RESC(a) do { if (__any((a) < 1.f)) { if (hi == 0) al_l[r32] = (a); asm volatile("s_waitcnt lgkmcnt(0)" ::: "memory"); \
    for (int d = 0; d < 4; ++d) for (int r = 0; r < 16; ++r) o[d][r] *= al_l[crow(r, hi)]; } } while (0)
  f32x16 pA0, pA1, pB0, pB1; float mnA, mnB, alA, alB; bf16x8 pa0, pa1, pa2, pa3; const int NT = seq / KVBLK;
  constexpr int SE = 0, SO = 1;
  SLOAD(SE, 0); asm volatile("s_waitcnt vmcnt(0)" ::: "memory"); SWRITE(0, SE); __syncthreads();
  qkt<NDK>(pA0, pA1, K_lds, qr, r32, hi); partialSM(pA0, pA1, m_reg, mnA, alA, C, thr);
  SLOAD(SO, KVBLK); if (2 < NT) SLOAD(SE, 2 * KVBLK);
  SWAIT(); SWRITE(1, SO); __syncthreads();
#pragma unroll 1
  for (int j = 1; j + 1 < NT; j += 2) {
    SBAR(); qkt<NDK>(pB0, pB1, K_lds + SHM_K, qr, r32, hi);
    finishSM(pA0, pA1, alA, l_reg, pa0, pa1, pa2, pa3); SBAR();
    SLOAD(SO, (j + 2) * KVBLK); SBAR();
    pv_d0(o, vb0, pa0, pa1, pa2, pa3); partialSM(pB0, pB1, m_reg, mnB, alB, C, thr);
    __syncthreads(); SWAIT(); SWRITE(0, SE);
    RESC(alB); __syncthreads();
    SBAR(); qkt<NDK>(pA0, pA1, K_lds, qr, r32, hi);
    finishSM(pB0, pB1, alB, l_reg, pa0, pa1, pa2, pa3); SBAR();
    if (j + 3 < NT) SLOAD(SE, (j + 3) * KVBLK); SBAR();
    pv_d0(o, vb0 + (int)SHM_V, pa0, pa1, pa2, pa3); partialSM(pA0, pA1, m_reg, mnA, alA, C, thr);
    __syncthreads(); SWAIT(); SWRITE(1, SO);
    RESC(alA); __syncthreads();
  }
  SBAR(); qkt<NDK>(pB0, pB1, K_lds + SHM_K, qr, r32, hi);
  finishSM(pA0, pA1, alA, l_reg, pa0, pa1, pa2, pa3); SBAR();
  pv_d0(o, vb0, pa0, pa1, pa2, pa3); partialSM(pB0, pB1, m_reg, mnB, alB, C, thr);
  __syncthreads(); RESC(alB);
  finishSM(pB0, pB1, alB, l_reg, pa0, pa1, pa2, pa3); SBAR();
  pv_d0(o, vb0 + (int)SHM_V, pa0, pa1, pa2, pa3);
  if (hi == 0) li_l[r32] = l_reg; asm volatile("s_waitcnt lgkmcnt(0)" ::: "memory");
  float rli[16];
#pragma unroll
  for (int r = 0; r < 16; ++r) rli[r] = __builtin_amdgcn_rcpf(li_l[crow(r, hi)]);
  bf16_t* Ow = Ob + (long)(wid * QBLK) * ldo;
#pragma unroll
  for (int r = 0; r < 16; ++r) { const int orow = crow(r, hi);
#pragma unroll
    for (int d0 = 0; d0 < 4; ++d0) Ow[(long)orow * ldo + d0 * 32 + r32] = f2bf(o[d0][r] * rli[r]); }
#undef SLOAD
#undef SWRITE
#undef SWAIT
#undef RESC
}

DI void ret_u_item(int n, int h, const bf16_t* __restrict__ PM, bf16_t* __restrict__ S, float lgf, float lgb) {
  __syncthreads();
  const int tid = otid(), wid = tid >> 6, lane = tid & 63, r32 = lane & 31, hi = lane >> 5;
  bf16_t* Vs = (bf16_t*)smem; bf16_t* Kf = Vs + 128 * 256; bf16_t* Kb = Kf + 128 * 128;
  const long r0 = (long)n * 128;
#pragma unroll
  for (int i = 0; i < 8; ++i) { const int id = tid + 512 * i, tok = id >> 5, c8 = id & 31;
    *(bf16x8*)(Vs + tok * 256 + c8 * 8) = ld8(PM + (r0 + tok) * PW + C_RV + h * 256 + c8 * 8); }
#pragma unroll
  for (int i = 0; i < 4; ++i) { const int id = tid + 512 * i, tok = id >> 4, c8 = id & 15;
    const bf16x8 kv = ld8(PM + (r0 + tok) * PW + C_RK + h * 128 + c8 * 8);
    const float zf = __builtin_amdgcn_exp2f(lgf * (float)(127 - tok)), zb = __builtin_amdgcn_exp2f(lgb * (float)tok);
    u32x4 of, ob;
#pragma unroll
    for (int j = 0; j < 4; ++j) { const float a = bf2f((bf16_t)kv[2 * j]), b = bf2f((bf16_t)kv[2 * j + 1]); of[j] = cvtpk(a * zf, b * zf); ob[j] = cvtpk(a * zb, b * zb); }
    *(u32x4*)(Kf + tok * 128 + c8 * 8) = of; *(u32x4*)(Kb + tok * 128 + c8 * 8) = ob; }
  __syncthreads();
  f32x16 acc[2][4];
#pragma unroll
  for (int d = 0; d < 2; ++d)
#pragma unroll
    for (int b = 0; b < 4; ++b) acc[d][b] = f32x16{};
#pragma unroll 1
  for (int ks = 0; ks < 8; ++ks) {
    const int t0 = ks * 16 + 8 * hi;
    bf16x8 a;
#pragma unroll
    for (int j = 0; j < 8; ++j) a[j] = (short)Vs[(t0 + j) * 256 + wid * 32 + r32];
#pragma unroll
    for (int b = 0; b < 4; ++b) { bf16x8 bf_, bb_;
#pragma unroll
      for (int j = 0; j < 8; ++j) { bf_[j] = (short)Kf[(t0 + j) * 128 + b * 32 + r32]; bb_[j] = (short)Kb[(t0 + j) * 128 + b * 32 + r32]; }
      acc[0][b] = MFMA32(a, bf_, acc[0][b]); acc[1][b] = MFMA32(a, bb_, acc[1][b]); }
  }
#pragma unroll
  for (int d = 0; d < 2; ++d) { bf16_t* Sp = S + ((long)(d * NCH + n) * 4 + h) * 32768;
#pragma unroll
    for (int b = 0; b < 4; ++b)
#pragma unroll
      for (int r = 0; r < 16; ++r) Sp[(wid * 32 + crow(r, hi)) * 128 + b * 32 + r32] = f2bf(acc[d][b][r]); }
}

DI void ret_scan(bf16_t* __restrict__ S, const float* lg2) {
  const int npairs = 2 * 65536;
  const int tid = otid();
  for (int pi = blockIdx.x * 512 + tid; pi < npairs; pi += gridDim.x * 512) {
    const int dir = pi >> 16, e = (pi & 65535) * 2, h = e >> 15;
    const float cd = __builtin_amdgcn_exp2f(lg2[dir * 4 + h] * 128.f);
    unsigned* base = (unsigned*)(S + (long)dir * NCH * 131072 + e);
    float s0 = 0.f, s1 = 0.f;
#pragma unroll 1
    for (int st0 = 0; st0 < NCH; st0 += 10) {
      unsigned u[10];
#pragma unroll
      for (int q = 0; q < 10; ++q) { const int st = st0 + q; const int n = dir == 0 ? st : (st == 0 ? 1 : (st == 1 ? 0 : 131 - st)); u[q] = base[(long)n * 65536]; }
#pragma unroll
      for (int q = 0; q < 10; ++q) { const int st = st0 + q; const int n = dir == 0 ? st : (st == 0 ? 1 : (st == 1 ? 0 : 131 - st));
        base[(long)n * 65536] = cvtpk(s0, s1);
        s0 = cd * s0 + __uint_as_float(u[q] << 16); s1 = cd * s1 + __uint_as_float(u[q] & 0xffff0000u); }
    }
  }
}

DI void ret_out_item(int n, int h, bf16_t* __restrict__ PM, const bf16_t* __restrict__ S, float lgf, float lgb) {
  __syncthreads();
  const int tid = otid(), wid = tid >> 6, lane = tid & 63, r32 = lane & 31, hi = lane >> 5;
  char* Qs = smem; bf16_t* Vs = (bf16_t*)(smem + 32768); char* Ks = smem + 98304; bf16_t* Yb = (bf16_t*)(smem + 98304);
  const long r0 = (long)n * 128;
#pragma unroll
  for (int i = 0; i < 8; ++i) { const int id = tid + 512 * i, tok = id >> 5, c8 = id & 31;
    *(bf16x8*)(Vs + tok * 256 + c8 * 8) = ld8(PM + (r0 + tok) * PW + C_RV + h * 256 + c8 * 8); }
#pragma unroll
  for (int i = 0; i < 4; ++i) { const int id = tid + 512 * i, tok = id >> 4, c8 = id & 15;
    *(bf16x8*)(Qs + KSWZ(tok, c8 * 16)) = ld8(PM + (r0 + tok) * PW + C_RQ + h * 128 + c8 * 8);
    *(bf16x8*)(Ks + KSWZ(tok, c8 * 16)) = ld8(PM + (r0 + tok) * PW + C_RK + h * 128 + c8 * 8); }
  __syncthreads();
  const int qb = wid & 3, dh = wid >> 2;
  const int qi = qb * 32 + r32;
  bf16x8 pf[4][2];
#pragma unroll
  for (int kb = 0; kb < 4; ++kb) { f32x16 pt = f32x16{};
#pragma unroll 2
    for (int ks = 0; ks < 8; ++ks) { const int cb = (ks * 16 + hi * 8) * 2;
      const bf16x8 kf = *(const bf16x8*)(Ks + KSWZ(kb * 32 + r32, cb)); const bf16x8 qf = *(const bf16x8*)(Qs + KSWZ(qi, cb)); pt = MFMA32(kf, qf, pt); }
#pragma unroll
    for (int r = 0; r < 16; ++r) { const int kj = kb * 32 + crow(r, hi); const float d = (float)(qi - kj);
      float w = 0.f; if (qi >= kj) w += __builtin_amdgcn_exp2f(lgf * d); if (kj >= qi) w += __builtin_amdgcn_exp2f(-lgb * d);
      pt[r] *= w; }
#pragma unroll
    for (int s = 0; s < 2; ++s) { u32x4 w = {cvtpk(pt[8 * s], pt[8 * s + 1]), cvtpk(pt[8 * s + 2], pt[8 * s + 3]), cvtpk(pt[8 * s + 4], pt[8 * s + 5]), cvtpk(pt[8 * s + 6], pt[8 * s + 7])};
      pf[kb][s] = *reinterpret_cast<bf16x8*>(&w); } }
  __syncthreads();
  const float xf = __builtin_amdgcn_exp2f(lgf * (float)(qi + 1)), xb = __builtin_amdgcn_exp2f(lgb * (float)(128 - qi));
  const bf16_t* Sf = S + ((long)(0 * NCH + n) * 4 + h) * 32768; const bf16_t* Sb = S + ((long)(1 * NCH + n) * 4 + h) * 32768;
#pragma unroll 1
  for (int d = 0; d < 4; ++d) { const int dvb = (dh * 4 + d) * 32; const int dv = dvb + r32;
    f32x16 a1 = f32x16{}, a2 = f32x16{};
#pragma unroll 2
    for (int ks = 0; ks < 8; ++ks) { const bf16x8 qf = *(const bf16x8*)(Qs + KSWZ(qi, (ks * 16 + hi * 8) * 2));
      a1 = MFMA32(ld8(Sf + dv * 128 + ks * 16 + hi * 8), qf, a1); a2 = MFMA32(ld8(Sb + dv * 128 + ks * 16 + hi * 8), qf, a2); }
#pragma unroll
    for (int r = 0; r < 16; ++r) a1[r] = a1[r] * xf + a2[r] * xb;
#pragma unroll
    for (int kb = 0; kb < 4; ++kb)
#pragma unroll
      for (int s = 0; s < 2; ++s) { bf16x8 a; const bf16_t* vb = Vs + (kb * 32 + 16 * s + 4 * hi) * 256 + dv;
#pragma unroll
        for (int j = 0; j < 8; ++j) a[j] = (short)vb[((j & 3) + 8 * (j >> 2)) * 256];
        a1 = MFMA32(a, pf[kb][s], a1); }
#pragma unroll
    for (int r = 0; r < 16; ++r) Yb[qi * 256 + ((dvb + crow(r, hi)) ^ r32)] = f2bf(a1[r]); }
  __syncthreads();
  { const int i = tid >> 2, qd = tid & 3; const bf16_t* yr = Yb + i * 256; const int sw = i & 31;
    float ss = 0.f;
#pragma unroll 8
    for (int c = 0; c < 64; ++c) { const float v = bf2f(yr[(qd * 64 + c) ^ sw]); ss += v * v; }
    ss += __shfl_xor(ss, 1); ss += __shfl_xor(ss, 2);
    const float rn = rsqrtf(ss * (1.f / 256.f) + 1e-6f);
    bf16_t* gp = PM + (r0 + i) * PW + C_RG + h * 256 + qd * 64;
#pragma unroll 1
    for (int c8 = 0; c8 < 8; ++c8) { const bf16x8 g = ld8(gp + c8 * 8); float o[8];
#pragma unroll
      for (int j = 0; j < 8; ++j) { const float gv = bf2f((bf16_t)g[j]); o[j] = gv * sigm(gv) * bf2f(yr[(qd * 64 + c8 * 8 + j) ^ sw]) * rn; }
      u32x4 w = {cvtpk(o[0], o[1]), cvtpk(o[2], o[3]), cvtpk(o[4], o[5]), cvtpk(o[6], o[7])}; *(u32x4*)(gp + c8 * 8) = w; } }
}

DI void conv_w(const float* __restrict__ W, bf16_t* __restrict__ Wt, int K, int N, int mode) {
  float* ldsf = (float*)smem; const int tid = otid(); const int nnt = N / 32, nt = nnt * (K / 128);
  for (int t = blockIdx.x; t < nt; t += gridDim.x) {
    const int n0 = (t % nnt) * 32, k0 = (t / nnt) * 128;
    __syncthreads();
    { const int n = tid & 31, kk = tid >> 5;
#pragma unroll
      for (int i = 0; i < 8; ++i) { const int k = kk + 16 * i; ldsf[n * 129 + k] = W[(long)(k0 + k) * N + n0 + n]; } }
    __syncthreads();
    { const int n = tid >> 4, k8 = (tid & 15) * 8; const float* s = ldsf + n * 129 + k8; const int sn = n0 + n; int dn = sn;
      if (mode == 1) dn = sn < NMAIN ? sn : sn + (GATE_ROW0 - NMAIN);
      if (mode == 2) dn = sn < FH ? ((sn >> 7) * 256 + (sn & 127)) : ((((sn - FH) >> 7) * 256) + 128 + ((sn - FH) & 127));
      u32x4 o = {cvtpk(s[0], s[1]), cvtpk(s[2], s[3]), cvtpk(s[4], s[5]), cvtpk(s[6], s[7])};
      *(u32x4*)(Wt + (long)dn * K + k0 + k8) = o; }
  }
}
DI void conv_layer(const Params& p, int l) {
  unsigned char* ws = p.ws;
  conv_w(p.w_in + (size_t)l * 1024 * 8224, (bf16_t*)(ws + O_WIN), 1024, 8224, 1);
  { u32x4 z = {0u, 0u, 0u, 0u}; u32x4* zp = (u32x4*)((bf16_t*)(ws + O_WIN) + (size_t)NMAIN * 1024);
    for (int i = blockIdx.x * 512 + otid(); i < (GATE_ROW0 - NMAIN) * 1024 / 8; i += gridDim.x * 512) zp[i] = z; }
  conv_w(p.w_mla_qb + (size_t)l * 256 * 768, (bf16_t*)(ws + O_QB), 256, 768, 0);
  conv_w(p.w_mla_kvb + (size_t)l * 256 * 1536, (bf16_t*)(ws + O_KVB), 256, 1536, 0);
  conv_w(p.w_ret_o + (size_t)l * 1024 * 1024, (bf16_t*)(ws + O_RO), 1024, 1024, 0);
  conv_w(p.w_mla_o + (size_t)l * 1024 * 1024, (bf16_t*)(ws + O_MO), 1024, 1024, 0);
  conv_w(p.w_gqa_o + (size_t)l * 1024 * 1024, (bf16_t*)(ws + O_GO), 1024, 1024, 0);
  conv_w(p.w_out + (size_t)l * 1024 * 1024, (bf16_t*)(ws + O_WO), 1024, 1024, 0);
  conv_w(p.w_ffn_in + (size_t)l * 1024 * 5632, (bf16_t*)(ws + O_FI), 1024, 5632, 2);
  conv_w(p.w_ffn_out + (size_t)l * FH * 1024, (bf16_t*)(ws + O_FO), FH, 1024, 0);
}

DI void norm_mod(const float* __restrict__ X, bf16_t* __restrict__ H, const float* __restrict__ g, const float* __restrict__ mods, int ishift, int iscale) {
  const int tid_ = otid(); const int wid = tid_ >> 6, lane = tid_ & 63;
  for (int row = blockIdx.x * 8 + wid; row < MR; row += gridDim.x * 8) {
    const float* xr = X + (long)row * 1024; const float* mv = mods + (row < CTXN ? 6144 : 0);
    f32x4 v[4]; float ss = 0.f;
#pragma unroll
    for (int i = 0; i < 4; ++i) { v[i] = *(const f32x4*)(xr + i * 256 + lane * 4); ss += v[i][0] * v[i][0] + v[i][1] * v[i][1] + v[i][2] * v[i][2] + v[i][3] * v[i][3]; }
    ss = wsum(ss); const float rn = rsqrtf(ss * (1.f / 1024.f) + 1e-6f);
#pragma unroll
    for (int i = 0; i < 4; ++i) { const int c = i * 256 + lane * 4; const f32x4 gg = *(const f32x4*)(g + c), sh = *(const f32x4*)(mv + ishift * 1024 + c), sl = *(const f32x4*)(mv + iscale * 1024 + c);
      float o[4];
#pragma unroll
      for (int j = 0; j < 4; ++j) o[j] = v[i][j] * rn * gg[j] * (1.f + sl[j]) + sh[j];
      u32x2 w = {cvtpk(o[0], o[1]), cvtpk(o[2], o[3])}; *(u32x2*)(H + (long)row * 1024 + c) = w; }
  }
}

DI void feat_pass(bf16_t* __restrict__ PM, const float* __restrict__ T128, const float* __restrict__ T32, const float* __restrict__ gq, const float* __restrict__ gkv,
                  const float* __restrict__ ggq, const float* __restrict__ ggk) {
  const int tid_ = otid(); const int wid = tid_ >> 6, lane = tid_ & 63;
  const int half = lane >> 5, j = lane & 31;
  for (int row = blockIdx.x * 8 + wid; row < MR; row += gridDim.x * 8) {
    bf16_t* pr = PM + (long)row * PW; const bool lat = row >= CTXN; const int t = row - CTXN; const int rp = lat ? (t >> 6) : 0, cp = lat ? (t & 63) : 0;
    const int pos = half ? cp : rp;
    float cs = 1.f, sn = 0.f; if (lat) { cs = T128[(pos * 32 + j) * 2]; sn = T128[(pos * 32 + j) * 2 + 1]; }
#pragma unroll
    for (int blk = 0; blk < 8; ++blk) { const int c1 = blk * 128 + half * 64 + j, c2 = c1 + 32; const float x1 = bf2f(pr[c1]), x2 = bf2f(pr[c2]);
      const float sc = blk >= 4 ? 0.08838834764831845f : 1.f;
      pr[c1] = f2bf((x1 * cs - x2 * sn) * sc); pr[c2] = f2bf((x2 * cs + x1 * sn) * sc); }
    { const u32x2 a = *(const u32x2*)(pr + C_CQ + lane * 4); float v[4] = {__uint_as_float(a[0] << 16), __uint_as_float(a[0] & 0xffff0000u), __uint_as_float(a[1] << 16), __uint_as_float(a[1] & 0xffff0000u)};
      float ss = wsum(v[0] * v[0] + v[1] * v[1] + v[2] * v[2] + v[3] * v[3]); const float rn = rsqrtf(ss * (1.f / 256.f) + 1e-6f); const f32x4 g = *(const f32x4*)(gq + lane * 4);
      u32x2 w = {cvtpk(v[0] * rn * g[0], v[1] * rn * g[1]), cvtpk(v[2] * rn * g[2], v[3] * rn * g[3])}; *(u32x2*)(pr + C_CQ + lane * 4) = w; }
    { const u32x2 a = *(const u32x2*)(pr + C_CKV + lane * 4); float v[4] = {__uint_as_float(a[0] << 16), __uint_as_float(a[0] & 0xffff0000u), __uint_as_float(a[1] << 16), __uint_as_float(a[1] & 0xffff0000u)};
      float ss = wsum(v[0] * v[0] + v[1] * v[1] + v[2] * v[2] + v[3] * v[3]); const float rn = rsqrtf(ss * (1.f / 256.f) + 1e-6f); const f32x4 g = *(const f32x4*)(gkv + lane * 4);
      u32x2 w = {cvtpk(v[0] * rn * g[0], v[1] * rn * g[1]), cvtpk(v[2] * rn * g[2], v[3] * rn * g[3])}; *(u32x2*)(pr + C_CKV + lane * 4) = w; }
    if (lat && lane < 16) { const int pi = lane, hh = pi >> 3, jj = pi & 7, c1 = C_KR + hh * 16 + jj, c2 = c1 + 8; const int ps = hh ? cp : rp;
      const float c_ = T32[(ps * 8 + jj) * 2], s_ = T32[(ps * 8 + jj) * 2 + 1]; const float x1 = bf2f(pr[c1]), x2 = bf2f(pr[c2]);
      pr[c1] = f2bf(x1 * c_ - x2 * s_); pr[c2] = f2bf(x2 * c_ + x1 * s_); }
#pragma unroll 1
    for (int hd = 0; hd < 10; ++hd) { const int base = hd < 8 ? C_GQ + hd * 128 : C_GK + (hd - 8) * 128; const float* gg = hd < 8 ? ggq : ggk;
      const int c1 = base + half * 64 + j, c2 = c1 + 32; const float x1 = bf2f(pr[c1]), x2 = bf2f(pr[c2]);
      const float ss = wsum(x1 * x1 + x2 * x2); const float rn = rsqrtf(ss * (1.f / 128.f) + 1e-6f);
      const float y1 = x1 * rn * gg[half * 64 + j], y2 = x2 * rn * gg[half * 64 + j + 32];
      pr[c1] = f2bf(y1 * cs - y2 * sn); pr[c2] = f2bf(y2 * cs + y1 * sn); }
  }
}

DI void mq_rope(bf16_t* __restrict__ MQ, const float* __restrict__ T32) {
  const int tid_ = otid(); const int wid = tid_ >> 6, lane = tid_ & 63;
  for (int row = CTXN + blockIdx.x * 8 + wid; row < MR; row += gridDim.x * 8) {
    const int t = row - CTXN, rp = t >> 6, cp = t & 63; bf16_t* pr = MQ + (long)row * 768;
#pragma unroll
    for (int i = 0; i < 2; ++i) { const int pp = lane + 64 * i, h = pp >> 4, pi = pp & 15, hh = pi >> 3, jj = pi & 7; const int c1 = h * 96 + 64 + hh * 16 + jj, c2 = c1 + 8; const int ps = hh ? cp : rp;
      const float c_ = T32[(ps * 8 + jj) * 2], s_ = T32[(ps * 8 + jj) * 2 + 1]; const float x1 = bf2f(pr[c1]), x2 = bf2f(pr[c2]);
      pr[c1] = f2bf(x1 * c_ - x2 * s_); pr[c2] = f2bf(x2 * c_ + x1 * s_); }
  }
}

DI void phase0(const Params& p) {
  unsigned char* ws = p.ws; const int tid = otid(); const long gt = (long)blockIdx.x * 512 + tid, gn = (long)gridDim.x * 512;
  { f32x4* X4 = (f32x4*)(ws + O_X); const f32x4* c4 = (const f32x4*)p.ctx; const f32x4* x4 = (const f32x4*)p.x;
    for (long i = gt; i < (long)MR * 256; i += gn) X4[i] = i < 65536 ? c4[i] : x4[i - 65536]; }
  { float* T128 = (float*)(ws + O_T128); float* T32 = (float*)(ws + O_T32);
    for (long i = gt; i < 256 * 32 + 256 * 8; i += gn) { int pos, jj; float inv; float* dst;
      if (i < 256 * 32) { pos = (int)i >> 5; jj = (int)i & 31; inv = powf(10000.f, -(float)jj / 32.f); dst = T128 + i * 2; }
      else { const int q = (int)i - 256 * 32; pos = q >> 3; jj = q & 7; inv = powf(10000.f, -(float)jj / 8.f); dst = T32 + (long)q * 2; }
      const float ang = (float)pos * inv; const float k = rintf(ang * 0.15915494309189535f);
      float r = fmaf(-k, 6.28318548202514648f, ang); r = fmaf(-k, -1.74845553e-07f, r);
      dst[0] = cosf(r); dst[1] = sinf(r); } }
  { float* sl = (float*)smem; float* red = sl + 2048; float* mods = (float*)(ws + O_MODS);
    for (int item = blockIdx.x; item < DEPTH * 48; item += gridDim.x) { const int l = item / 48, cg0 = (item % 48) * 128;
      __syncthreads();
      for (int k = tid; k < 1024; k += 512) { const float a = p.c[k], b = p.c_ctx[k]; sl[k] = a * sigm(a); sl[1024 + k] = b * sigm(b); }
      __syncthreads();
      const int col = tid & 127, ks = tid >> 7; const float* w = p.w_mod + ((size_t)l * 1024 + ks * 256) * 6144 + cg0 + col;
      float a0 = 0.f, a1 = 0.f;
#pragma unroll 8
      for (int k = 0; k < 256; ++k) { const float wv = w[(size_t)k * 6144]; a0 = fmaf(sl[ks * 256 + k], wv, a0); a1 = fmaf(sl[1024 + ks * 256 + k], wv, a1); }
      red[(ks * 128 + col) * 2] = a0; red[(ks * 128 + col) * 2 + 1] = a1;
      __syncthreads();
      if (tid < 256) { const int cc = tid & 127, which = tid >> 7; float s = 0.f;
        for (int q = 0; q < 4; ++q) s += red[(q * 128 + cc) * 2 + which];
        mods[((size_t)l * 2 + which) * 6144 + cg0 + cc] = s + p.b_mod[(size_t)l * 6144 + cg0 + cc]; } } }
}

DI void final_norm(const float* __restrict__ X, const float* __restrict__ g, float* __restrict__ out) {
  const int tid_ = otid(); const int wid = tid_ >> 6, lane = tid_ & 63;
  for (int t = blockIdx.x * 8 + wid; t < SEQL; t += gridDim.x * 8) {
    const float* xr = X + (long)(CTXN + t) * 1024; f32x4 v[4]; float ss = 0.f;
#pragma unroll
    for (int i = 0; i < 4; ++i) { v[i] = *(const f32x4*)(xr + i * 256 + lane * 4); ss += v[i][0] * v[i][0] + v[i][1] * v[i][1] + v[i][2] * v[i][2] + v[i][3] * v[i][3]; }
    ss = wsum(ss); const float rn = rsqrtf(ss * (1.f / 1024.f) + 1e-6f);
#pragma unroll
    for (int i = 0; i < 4; ++i) { const int c = i * 256 + lane * 4; const f32x4 gg = *(const f32x4*)(g + c); *(f32x4*)(out + (long)t * 1024 + c) = v[i] * rn * gg; }
  }
}

#define WSP(T, off) ((T*)(ws + (off)))
#define PHASE_BEGIN const Params& p = kargs(); unsigned char* ws = p.ws;
__global__ void __launch_bounds__(512) mega(Params p_unused) {
  cg::grid_group grid = cg::this_grid();
  constexpr int NM = MR / 256;
  const float LOG2E = 1.4426950408889634f;
  const float mlaC = 0.10206207261596577f * LOG2E, mlaT = 8.f / 0.10206207261596577f, gqaC = 0.08838834764831845f * LOG2E, gqaT = 8.f / 0.08838834764831845f;

  { const Params& p = kargs(); phase0(p); }
  { const Params& p = kargs(); conv_layer(p, 0); }
  grid.sync();
#pragma unroll 1
  for (int l = 0; l < DEPTH; ++l) {
    const bool need_ctx = l < DEPTH - 1;
    { PHASE_BEGIN
    if (l > 0) conv_layer(kargs(), l);
    norm_mod(WSP(float, O_X), WSP(bf16_t, O_H), p.g_mix + l * 1024, WSP(float, O_MODS) + (size_t)l * 2 * 6144, 0, 1);
    }
    grid.sync();
    { PHASE_BEGIN
    gemm_phase<false>(WSP(bf16_t, O_H), 1024, WSP(bf16_t, O_WIN), 1024, 1024, NM, PW / 256, EpiStore{WSP(bf16_t, O_PM), PW, 0});
    }
    grid.sync();
    { PHASE_BEGIN
    feat_pass(WSP(bf16_t, O_PM), WSP(float, O_T128), WSP(float, O_T32), p.g_mla_q + l * 256, p.g_mla_kv + l * 256, p.g_gqa_q + l * 128, p.g_gqa_k + l * 128);
    }
    grid.sync();
    { PHASE_BEGIN
    gemm_phase<false>(WSP(bf16_t, O_PM) + C_CQ, PW, WSP(bf16_t, O_QB), 256, 256, NM, 3, EpiStore{WSP(bf16_t, O_MQ), 768, 0});
    gemm_phase<false>(WSP(bf16_t, O_PM) + C_CKV, PW, WSP(bf16_t, O_KVB), 256, 256, NM, 6, EpiStore{WSP(bf16_t, O_MKV), 1536, 0});
#pragma unroll 1
    for (int it = blockIdx.x; it < NCH * 4; it += gridDim.x) ret_u_item(it >> 2, it & 3, WSP(bf16_t, O_PM), WSP(bf16_t, O_S), p.lg2[it & 3], p.lg2[4 + (it & 3)]);
    }
    grid.sync();
    { PHASE_BEGIN
    mq_rope(WSP(bf16_t, O_MQ), WSP(float, O_T32));
    ret_scan(WSP(bf16_t, O_S), p.lg2);
    }
    grid.sync();
    { PHASE_BEGIN
    { bf16_t* PM = WSP(bf16_t, O_PM);
      const int nlat = 512, nctx = need_ctx ? 8 : 0;
#pragma unroll 1
      for (int it = blockIdx.x; it < nlat + nctx; it += gridDim.x) { const int hd = it & 7, qb = it >> 3; const bool isc = it >= nlat;
        const long q0 = (isc ? 0 : (long)(CTXN + qb * 256) * PW) + C_GQ + hd * 128;
        attn_item<8>(PM + q0, PW, PM + C_GK + (hd >> 2) * 128, PW, PM, 0, PM + C_GV + (hd >> 2) * 128, PW, PM + q0, PW, isc ? CTXN : MR, gqaC, gqaT); }
      const int n0 = need_ctx ? 0 : 2;
#pragma unroll 1
      for (int it = blockIdx.x; it < (NCH - n0) * 4; it += gridDim.x) { const int n = n0 + (it >> 2), h = it & 3; ret_out_item(n, h, PM, WSP(bf16_t, O_S), p.lg2[h], p.lg2[4 + h]); } }
    }
    grid.sync();
    { PHASE_BEGIN
    { bf16_t* PM = WSP(bf16_t, O_PM); const bf16_t* MQ = WSP(bf16_t, O_MQ); const bf16_t* MKV = WSP(bf16_t, O_MKV);
#pragma unroll 1
      for (int it = blockIdx.x; it < 512 + (need_ctx ? 8 : 0); it += gridDim.x) {
        const int hd = it & 7; const bool isc = it >= 512; const int qb = it >> 3; const long rq = isc ? 0 : (long)(CTXN + qb * 256);
        attn_item<6>(MQ + rq * 768 + hd * 96, 768, MKV + hd * 192, 1536, PM + C_KR, PW, MKV + hd * 192 + 64, 1536, PM + rq * PW + C_RQ + hd * 128, PW, isc ? CTXN : MR, mlaC, mlaT); } }
    }
    grid.sync();
    { PHASE_BEGIN
    gemm_phase<false>(WSP(bf16_t, O_H), 1024, WSP(bf16_t, O_WIN) + (size_t)GATE_ROW0 * 1024, 1024, 1024, NM, 12, EpiStore{WSP(bf16_t, O_GATES), 3072, 1});
    }
    grid.sync();
    { PHASE_BEGIN
    gemm_phase<true>(WSP(bf16_t, O_PM), PW, WSP(bf16_t, O_RO), 1024, 1024, NM, 4, EpiMerge{WSP(float, O_ZF), WSP(bf16_t, O_GATES), WSP(bf16_t, O_PM) + C_RV, PW});
    }
    grid.sync();
    { PHASE_BEGIN
    gemm_phase<false>(WSP(bf16_t, O_PM) + C_RV, PW, WSP(bf16_t, O_WO), 1024, 1024, NM, 4, EpiResid{WSP(float, O_X), WSP(float, O_MODS) + (size_t)l * 2 * 6144, 2});
    }
    grid.sync();
    { PHASE_BEGIN
    norm_mod(WSP(float, O_X), WSP(bf16_t, O_H), p.g_ffn + l * 1024, WSP(float, O_MODS) + (size_t)l * 2 * 6144, 3, 4);
    }
    grid.sync();
    { PHASE_BEGIN
    gemm_phase<false>(WSP(bf16_t, O_H), 1024, WSP(bf16_t, O_FI), 1024, 1024, NM, 22, EpiSwiglu{WSP(bf16_t, O_ACT)});
    }
    grid.sync();
    { PHASE_BEGIN
    gemm_phase<false>(WSP(bf16_t, O_ACT), FH, WSP(bf16_t, O_FO), FH, FH, NM, 4, EpiResid{WSP(float, O_X), WSP(float, O_MODS) + (size_t)l * 2 * 6144, 5});
    }
    grid.sync();
  }
  { PHASE_BEGIN final_norm(WSP(float, O_X), p.g_final, p.out); }
}

extern "C" void kernel_launch(void* const* d_in, const int* in_sizes, int n_in, void* d_out, int out_size, void* d_ws, size_t ws_size, hipStream_t stream) {
  static int grid_blocks = 0;
  if (grid_blocks == 0) {
    if (n_in != 22 || ws_size < WS_END || out_size != SEQL * DM) { fprintf(stderr, "kernel_launch: unexpected shapes n_in %d ws %zu (need %zu) out %d\n", n_in, ws_size, (size_t)WS_END, out_size); grid_blocks = -1; return; }
    int dev = 0, cus = 0, per_cu = 0;
    hipGetDevice(&dev); hipDeviceGetAttribute(&cus, hipDeviceAttributeMultiprocessorCount, dev);
    if (hipFuncSetAttribute((const void*)mega, hipFuncAttributeMaxDynamicSharedMemorySize, LDS_BYTES) != hipSuccess) { fprintf(stderr, "kernel_launch: hipFuncSetAttribute failed\n"); grid_blocks = -1; return; }
    if (hipOccupancyMaxActiveBlocksPerMultiprocessor(&per_cu, (const void*)mega, 512, LDS_BYTES) != hipSuccess || per_cu < 1) { fprintf(stderr, "kernel_launch: occupancy query failed (%d)\n", per_cu); per_cu = 1; (void)hipGetLastError(); }
    grid_blocks = cus * 1;
  }
  if (grid_blocks < 0) return;
  Params p{};
  const float** pp = (const float**)&p;
  for (int i = 0; i < 22; ++i) pp[i] = (const float*)d_in[i];
  p.out = (float*)d_out; p.ws = (unsigned char*)d_ws;
  for (int h = 0; h < 4; ++h) { p.lg2[h] = (float)(log1p(-exp2(-5.0 - h)) / log(2.0)); p.lg2[4 + h] = (float)(log1p(-exp2(-5.5 - h)) / log(2.0)); }
  void* args[] = {&p};
  hipError_t e = hipLaunchCooperativeKernel((const void*)mega, dim3(grid_blocks), dim3(512), args, LDS_BYTES, stream);
  if (e != hipSuccess) fprintf(stderr, "cooperative launch failed: %s (grid %d)\n", hipGetErrorString(e), grid_blocks);
}
```

```cpp
#include <hip/hip_runtime.h>
#include <hip/hip_cooperative_groups.h>
#include <cmath>
#include <cstdio>
#include <cstdint>
namespace cg = cooperative_groups;

#define DI __device__ __forceinline__
typedef unsigned short bf16_t;
using bf16x8 = __attribute__((ext_vector_type(8))) short;
using s16x4  = __attribute__((ext_vector_type(4))) short;
using f32x16 = __attribute__((ext_vector_type(16))) float;
using f32x4  = __attribute__((ext_vector_type(4))) float;
using u32x4  = __attribute__((ext_vector_type(4))) unsigned;
using u32x2  = __attribute__((ext_vector_type(2))) unsigned;

constexpr int DM = 1024, SEQL = 16384, CTXN = 256, MR = SEQL + CTXN, DEPTH = 4;
constexpr int PW = 5376;
constexpr int C_RQ = 0, C_RK = 512, C_RV = 1024, C_RG = 2048, C_CQ = 3072, C_CKV = 3328, C_KR = 3584, C_GQ = 3616, C_GK = 4640, C_GV = 4896;
constexpr int NMAIN = 5152, NINROWS = 8448, GATE_ROW0 = 5376;
constexpr int FH = 2816, NCH = 130;
constexpr int LDS_BYTES = 163840;

constexpr size_t SZ_WIN = (size_t)NINROWS * 1024 * 2, SZ_QB = 768 * 256 * 2, SZ_KVB = 1536 * 256 * 2, SZ_SQ = 1024 * 1024 * 2,
                 SZ_FI = (size_t)5632 * 1024 * 2, SZ_FO = (size_t)1024 * FH * 2;
constexpr size_t O_WIN = 0, O_QB = O_WIN + SZ_WIN, O_KVB = O_QB + SZ_QB, O_RO = O_KVB + SZ_KVB, O_MO = O_RO + SZ_SQ, O_GO = O_MO + SZ_SQ,
                 O_WO = O_GO + SZ_SQ, O_FI = O_WO + SZ_SQ, O_FO = O_FI + SZ_FI, O_WEND = O_FO + SZ_FO;
constexpr size_t O_X = O_WEND, SZ_X = (size_t)MR * 1024 * 4;
constexpr size_t O_PM = O_X + SZ_X, SZ_PM = (size_t)MR * PW * 2;
constexpr size_t O_CB = O_PM + SZ_PM;
constexpr size_t SZ_H = (size_t)MR * 1024 * 2, SZ_S = (size_t)NCH * 2 * 4 * 256 * 128 * 2, SZ_MQ = (size_t)MR * 768 * 2, SZ_MKV = (size_t)MR * 1536 * 2;
constexpr size_t O_H = O_CB, O_S = O_H + SZ_H, O_MQ = O_S + SZ_S, O_MKV = O_MQ + SZ_MQ, O_CBEND = O_MKV + SZ_MKV;
constexpr size_t O_ZF = O_CB, SZ_ZF = (size_t)MR * 1024 * 4, O_GATES = O_ZF + SZ_ZF, SZ_GATES = (size_t)MR * 3072 * 2;
static_assert(O_GATES + SZ_GATES <= O_CBEND, "gates alias");
constexpr size_t O_MODS = O_CBEND, SZ_MODS = (size_t)DEPTH * 2 * 6144 * 4;
constexpr size_t O_T128 = O_MODS + SZ_MODS, SZ_T128 = 256 * 32 * 2 * 4, O_T32 = O_T128 + SZ_T128, SZ_T32 = 256 * 8 * 2 * 4, WS_END = O_T32 + SZ_T32;
constexpr size_t O_ACT = O_PM;
static_assert((size_t)MR * FH * 2 <= SZ_PM, "act alias");

struct Params {
  const float *x, *c, *ctx, *c_ctx, *w_mod, *b_mod, *g_mix, *w_in, *g_mla_q, *g_mla_kv, *w_mla_qb, *w_mla_kvb, *g_gqa_q, *g_gqa_k,
              *w_ret_o, *w_mla_o, *w_gqa_o, *w_out, *g_ffn, *w_ffn_in, *w_ffn_out, *g_final;
  float* out; unsigned char* ws;
  float lg2[8];
};

extern __shared__ __attribute__((aligned(16))) char smem[];
__device__ __forceinline__ const Params& kargs() { int z = 0; asm volatile("" : "+s"(z)); return *(const Params*)((const char*)__builtin_amdgcn_kernarg_segment_ptr() + z); }

DI float bf2f(bf16_t b) { return __uint_as_float(((unsigned)b) << 16); }
typedef __bf16 bf16v2_t __attribute__((ext_vector_type(2)));
typedef float f32v2_t __attribute__((ext_vector_type(2)));
DI unsigned cvtpk(float lo, float hi) { f32v2_t v = {lo, hi}; bf16v2_t b = __builtin_convertvector(v, bf16v2_t); return __builtin_bit_cast(unsigned, b); }
DI bf16_t f2bf(float x) { return (bf16_t)(cvtpk(x, 0.f) & 0xffffu); }
DI float wsum(float v) { for (int o = 32; o > 0; o >>= 1) v += __shfl_xor(v, o); return v; }
DI int crow(int r, int hi) { return (r & 3) + 8 * (r >> 2) + 4 * hi; }
DI bf16x8 ld8(const bf16_t* p) { return *reinterpret_cast<const bf16x8*>(p); }
DI float sigm(float v) { return 1.f / (1.f + __expf(-v)); }
DI int otid() { int t = threadIdx.x; asm volatile("" : "+v"(t)); return t; }
DI unsigned char* opq(unsigned char* q) { int z = 0; asm volatile("" : "+s"(z)); return q + z; }
#define SBAR() __builtin_amdgcn_sched_barrier(0)
#define MFMA32(a, b, c) __builtin_amdgcn_mfma_f32_32x32x16_bf16((a), (b), (c), 0, 0, 0)

#define LAS __attribute__((address_space(3)))
constexpr int BK = 64, HALF = 128, HTB = HALF * BK * 2;
DI int lds_byte(int r, int c) { const int st = (r >> 4) * 2 + (c >> 5), rr = r & 15, cc = c & 31, ob = rr * 64 + cc * 2; return st * 1024 + (ob ^ (((ob >> 9) & 1) << 5)); }
DI void stage_rc(int b, int& R, int& C) { const int st = b / 1024, sb = b % 1024, swz = sb ^ (((sb >> 9) & 1) << 5); R = (st >> 1) * 16 + swz / 64; C = (st & 1) * 32 + (swz % 64) / 2; }
typedef f32x4 acc_t[2][2][4][2];

DI bool tile_map(int idx, int nM, int nN, int& pm, int& pn) {
  const int nwg = nM * nN; if (idx >= nwg) return false;
  int wgid = idx; { const int q = nwg / 8, r = nwg % 8, xcd = wgid % 8, off = wgid / 8; wgid = (xcd < r ? xcd * (q + 1) : r * (q + 1) + (xcd - r) * q) + off; }
  const int nig = 8 * nN, gid = wgid / nig, fm = gid * 8, gsz = (nM - fm) < 8 ? (nM - fm) : 8;
  pm = fm + ((wgid % nig) % gsz); pn = (wgid % nig) / gsz; return true;
}
struct Unit { int pm, pn, b; };
template <bool MERGE>
DI bool unit_next(int nM, int nN, int pm0, int ui, Unit& u) {
  const int ti = MERGE ? ui / 3 : ui; u.b = MERGE ? ui - ti * 3 : 0;
  const bool ok = tile_map(ti * (int)gridDim.x + (int)blockIdx.x, nM, nN, u.pm, u.pn); u.pm += pm0; return ok;
}
template <bool MERGE>
DI const char* unit_A(const bf16_t* A, int lda, const Unit& u) { const int off = MERGE ? (u.b == 0 ? C_RG : (u.b == 1 ? C_RQ : C_GQ)) : 0; return (const char*)(A + off) + (size_t)u.pm * 512 * lda; }
template <bool MERGE>
DI const char* unit_B(const bf16_t* B, int ldb, const Unit& u) { return (const char*)(B + (MERGE ? (size_t)u.b * 1024 * 1024 : 0)) + (size_t)u.pn * 512 * ldb; }

template <bool MERGE, class Epi>
DI void gemm_phase(const bf16_t* __restrict__ gA, const int lda, const bf16_t* __restrict__ gB, const int ldb, const int K, const int nM, const int nN, const Epi& E, const int pm0 = 0) {
  LAS unsigned char* lds = (LAS unsigned char*)smem;
  const int tid = otid(), wid = __builtin_amdgcn_readfirstlane(tid >> 6), lane = tid & 63, wr = wid >> 2, wc = wid & 3, fr = lane & 15, fq = lane >> 4;
  const int nt = K / BK;
  unsigned voffA[2], voffB[2];
#pragma unroll
  for (int i = 0; i < 2; ++i) { int R, C; stage_rc(tid * 16 + i * 8192, R, C); voffA[i] = (unsigned)(R * lda + C) * 2u; voffB[i] = (unsigned)(R * ldb + C) * 2u; }
  const size_t kstep = (size_t)(BK * 2);
  const size_t hstepA = (size_t)HALF * lda * 2, hstepB = (size_t)HALF * ldb * 2;
  const unsigned ldsw = (unsigned)wid * 1024u;
  const int aoff = lds_byte(wr * 64 + fr, fq * 8), boff = lds_byte(wc * 32 + fr, fq * 8);
#define PG8_SA(b, h) (((b) * 2 + (h)) * HTB)
#define PG8_SB(b, h) ((4 + (b) * 2 + (h)) * HTB)
#define PG8_STAGE(bufoff, gbase, voff) do { _Pragma("unroll") for (int _i = 0; _i < 2; ++_i) \
    __builtin_amdgcn_global_load_lds((const unsigned*)((const char*)(gbase) + (voff)[_i]), (LAS unsigned*)(lds + (bufoff) + ldsw + _i * 8192), 16, 0, 0); } while (0)
#define PG8_LDA(dst, b, h) do { _Pragma("unroll") for (int m = 0; m < 4; ++m) _Pragma("unroll") for (int k = 0; k < 2; ++k) dst[m][k] = *(const LAS bf16x8*)(lds + PG8_SA(b, h) + aoff + m * 2048 + k * 1024); } while (0)
#define PG8_LDB(dst, b, h) do { _Pragma("unroll") for (int n = 0; n < 2; ++n) _Pragma("unroll") for (int k = 0; k < 2; ++k) dst[n][k] = *(const LAS bf16x8*)(lds + PG8_SB(b, h) + boff + n * 2048 + k * 1024); } while (0)
#define PG8_MMA(ai, bj, At, Bt) do { __builtin_amdgcn_s_setprio(1); _Pragma("unroll") for (int m = 0; m < 4; ++m) _Pragma("unroll") for (int n = 0; n < 2; ++n) _Pragma("unroll") for (int k = 0; k < 2; ++k) \
    acc[ai][bj][m][n] = __builtin_amdgcn_mfma_f32_16x16x32_bf16(Bt[n][k], At[m][k], acc[ai][bj][m][n], 0, 0, 0); __builtin_amdgcn_s_setprio(0); } while (0)
#define PG8_WAIT_V(n) asm volatile("s_waitcnt vmcnt(" #n ")" ::: "memory")
#define PG8_WAIT_L(n) asm volatile("s_waitcnt lgkmcnt(" #n ")" ::: "memory")
#define PG8_BAR __builtin_amdgcn_s_barrier()
#define PG8_SCHED __builtin_amdgcn_sched_barrier(0)
  Unit cur, nxt; int ui = 0;
  if (!unit_next<MERGE>(nM, nN, pm0, 0, cur)) return;
  f32x4 acc[2][2][4][2];
#pragma unroll
  for (int a = 0; a < 2; ++a)
#pragma unroll
    for (int b = 0; b < 2; ++b)
#pragma unroll
      for (int m = 0; m < 4; ++m)
#pragma unroll
        for (int n = 0; n < 2; ++n) acc[a][b][m][n] = (f32x4){0.f, 0.f, 0.f, 0.f};
  bf16x8 At[4][2], B0[2][2], B1[2][2];
  const char* cA = unit_A<MERGE>(gA, lda, cur); const char* cB = unit_B<MERGE>(gB, ldb, cur);
  PG8_STAGE(PG8_SB(0, 0), cB, voffB); PG8_STAGE(PG8_SA(0, 0), cA, voffA); PG8_STAGE(PG8_SB(0, 1), cB + hstepB, voffB); PG8_STAGE(PG8_SA(0, 1), cA + hstepA, voffA);
  if (wr == 1) PG8_BAR;
  PG8_WAIT_V(4); PG8_BAR;
  PG8_STAGE(PG8_SB(1, 0), cB + kstep, voffB); PG8_STAGE(PG8_SA(1, 0), cA + kstep, voffA); PG8_STAGE(PG8_SB(1, 1), cB + hstepB + kstep, voffB);
  PG8_WAIT_V(6); PG8_BAR;
  for (;;) {
    const bool has_next = unit_next<MERGE>(nM, nN, pm0, ui + 1, nxt);
    const char* nA = has_next ? unit_A<MERGE>(gA, lda, nxt) : cA; const char* nB = has_next ? unit_B<MERGE>(gB, ldb, nxt) : cB;
#pragma unroll 1
    for (int t = 0; t < nt; t += 2) {
      const bool last = (t == nt - 2);
      const char* a1 = cA + (size_t)(t + 1) * kstep;
      const char* a2 = last ? nA : cA + (size_t)(t + 2) * kstep; const char* b2 = last ? nB : cB + (size_t)(t + 2) * kstep;
      const char* a3 = a2 + kstep; const char* b3 = b2 + kstep;
      PG8_LDB(B0, 0, 0); PG8_SCHED; PG8_LDA(At, 0, 0); PG8_STAGE(PG8_SA(1, 1), a1 + hstepA, voffA);
      PG8_WAIT_L(8); PG8_BAR; PG8_WAIT_L(0); PG8_MMA(0, 0, At, B0); PG8_BAR; PG8_SCHED;
      PG8_LDB(B1, 0, 1); PG8_STAGE(PG8_SB(0, 0), b2, voffB);
      PG8_BAR; PG8_WAIT_L(0); PG8_MMA(0, 1, At, B1); PG8_BAR;
      PG8_LDA(At, 0, 1); PG8_STAGE(PG8_SA(0, 0), a2, voffA);
      PG8_BAR; PG8_WAIT_L(0); PG8_MMA(1, 0, At, B0); PG8_BAR; PG8_SCHED;
      PG8_STAGE(PG8_SB(0, 1), b2 + hstepB, voffB);
      PG8_WAIT_V(6); PG8_BAR; PG8_MMA(1, 1, At, B1); PG8_BAR;
      PG8_LDB(B0, 1, 0); PG8_SCHED; PG8_LDA(At, 1, 0); PG8_STAGE(PG8_SA(0, 1), a2 + hstepA, voffA);
      PG8_WAIT_L(8); PG8_BAR; PG8_WAIT_L(0); PG8_MMA(0, 0, At, B0); PG8_BAR; PG8_SCHED;
      PG8_LDB(B1, 1, 1); PG8_STAGE(PG8_SB(1, 0), b3, voffB);
      PG8_BAR; PG8_WAIT_L(0); PG8_MMA(0, 1, At, B1); PG8_BAR;
      PG8_LDA(At, 1, 1); PG8_STAGE(PG8_SA(1, 0), a3, voffA);
      PG8_BAR; PG8_WAIT_L(0); PG8_MMA(1, 0, At, B0); PG8_BAR; PG8_SCHED;
      PG8_STAGE(PG8_SB(1, 1), b3 + hstepB, voffB);
      PG8_WAIT_V(6); PG8_BAR; PG8_MMA(1, 1, At, B1); PG8_BAR;
    }
    E(acc, cur.pm, cur.pn, cur.b, wr, wc, fr, fq);
    if (!has_next) break;
#pragma unroll
    for (int a = 0; a < 2; ++a)
#pragma unroll
      for (int b = 0; b < 2; ++b)
#pragma unroll
        for (int m = 0; m < 4; ++m)
#pragma unroll
          for (int n = 0; n < 2; ++n) acc[a][b][m][n] = (f32x4){0.f, 0.f, 0.f, 0.f};
    cur = nxt; cA = nA; cB = nB; ++ui;
  }
  PG8_WAIT_V(0);
  if (wr == 0) PG8_BAR;
  PG8_BAR;
#undef PG8_SA
#undef PG8_SB
#undef PG8_STAGE
#undef PG8_LDA
#undef PG8_LDB
#undef PG8_MMA
}

struct EpiStore { bf16_t* C; long ldc; int sig;
  DI void operator()(const acc_t& acc, int pm, int pn, int ub, int wr, int wc, int fr, int fq) const {
#pragma unroll
    for (int ai = 0; ai < 2; ++ai)
#pragma unroll
      for (int m = 0; m < 4; ++m) { bf16_t* rp = C + (long)(pm * 256 + ai * 128 + wr * 64 + m * 16 + fr) * ldc + pn * 256 + wc * 32 + fq * 4;
#pragma unroll
        for (int bj = 0; bj < 2; ++bj)
#pragma unroll
          for (int n = 0; n < 2; ++n) { f32x4 v = acc[ai][bj][m][n];
            if (sig) { v[0] = sigm(v[0]); v[1] = sigm(v[1]); v[2] = sigm(v[2]); v[3] = sigm(v[3]); }
            u32x2 o = {cvtpk(v[0], v[1]), cvtpk(v[2], v[3])}; *(u32x2*)(rp + bj * 128 + n * 16) = o; } } } };
struct EpiMerge { float* zf; const bf16_t* gates; bf16_t* zb; long ldz;
  DI void operator()(const acc_t& acc, int pm, int pn, int b, int wr, int wc, int fr, int fq) const {
#pragma unroll
    for (int ai = 0; ai < 2; ++ai)
#pragma unroll
      for (int m = 0; m < 4; ++m) { const long row = pm * 256 + ai * 128 + wr * 64 + m * 16 + fr; const int c0 = pn * 256 + wc * 32 + fq * 4;
#pragma unroll
        for (int bj = 0; bj < 2; ++bj)
#pragma unroll
          for (int n = 0; n < 2; ++n) { const int col = c0 + bj * 128 + n * 16; const f32x4 v = acc[ai][bj][m][n];
            const u32x2 g = *(const u32x2*)(gates + row * 3072 + b * 1024 + col);
            f32x4 z = {v[0] * __uint_as_float(g[0] << 16), v[1] * __uint_as_float(g[0] & 0xffff0000u), v[2] * __uint_as_float(g[1] << 16), v[3] * __uint_as_float(g[1] & 0xffff0000u)};
            float* zp = zf + row * 1024 + col;
            if (b) z += *(const f32x4*)zp;
            if (b == 2) { u32x2 o = {cvtpk(z[0], z[1]), cvtpk(z[2], z[3])}; *(u32x2*)(zb + row * ldz + col) = o; } else *(f32x4*)zp = z; } } } };
struct EpiResid { float* X; const float* mods; int mi;
  DI void operator()(const acc_t& acc, int pm, int pn, int ub, int wr, int wc, int fr, int fq) const {
    const float* mv = mods + (pm == 0 ? 6144 : 0) + mi * 1024;
#pragma unroll
    for (int ai = 0; ai < 2; ++ai)
#pragma unroll
      for (int m = 0; m < 4; ++m) { const long row = pm * 256 + ai * 128 + wr * 64 + m * 16 + fr; const int c0 = pn * 256 + wc * 32 + fq * 4;
#pragma unroll
        for (int bj = 0; bj < 2; ++bj)
#pragma unroll
          for (int n = 0; n < 2; ++n) { const int col = c0 + bj * 128 + n * 16; float* xp = X + row * 1024 + col;
            const f32x4 g = *(const f32x4*)(mv + col); *(f32x4*)xp = *(const f32x4*)xp + g * acc[ai][bj][m][n]; } } } };
struct EpiSwiglu { bf16_t* act;
  DI void operator()(const acc_t& acc, int pm, int pn, int ub, int wr, int wc, int fr, int fq) const {
#pragma unroll
    for (int ai = 0; ai < 2; ++ai)
#pragma unroll
      for (int m = 0; m < 4; ++m) { bf16_t* rp = act + (long)(pm * 256 + ai * 128 + wr * 64 + m * 16 + fr) * FH + pn * 128 + wc * 32 + fq * 4;
#pragma unroll
        for (int n = 0; n < 2; ++n) { const f32x4 a = acc[ai][0][m][n], b = acc[ai][1][m][n];
          u32x2 o = {cvtpk(a[0] * sigm(a[0]) * b[0], a[1] * sigm(a[1]) * b[1]), cvtpk(a[2] * sigm(a[2]) * b[2], a[3] * sigm(a[3]) * b[3])};
          *(u32x2*)(rp + n * 16) = o; } } } };


DI void ctx_tile(const bf16_t* __restrict__ A, long lda, const bf16_t* __restrict__ B, long ldb, int K, int row0, int col0, float (&out)[2]) {
  const int tid = otid(), wid = tid >> 6, lane = tid & 63, r32 = lane & 31, hi = lane >> 5;
  float* red = (float*)smem;
  const bf16_t* ap = A + (long)(row0 + r32) * lda + hi * 8; const bf16_t* bp = B + (long)(col0 + r32) * ldb + hi * 8;
  f32x16 acc = f32x16{};
  const int nks = K >> 4;
#pragma unroll 4
  for (int ks = wid; ks < nks; ks += 8) acc = MFMA32(ld8(ap + ks * 16), ld8(bp + ks * 16), acc);
  __syncthreads();
#pragma unroll
  for (int r = 0; r < 16; ++r) red[(wid * 32 + crow(r, hi)) * 32 + r32] = acc[r];
  __syncthreads();
#pragma unroll
  for (int s = 0; s < 2; ++s) { const int e = tid + 512 * s; float v = 0.f;
#pragma unroll
    for (int w = 0; w < 8; ++w) v += red[w * 1024 + e];
    out[s] = v; }
}

constexpr int QBLK = 32, KVBLK = 64;
constexpr size_t SHM_V = KVBLK * 128 * 2, SHM_K = KVBLK * 128 * 2;
#define KSWZ(row, colB) ((row) * 256 + ((colB) ^ (((row) & 7) << 4)))

DI void partialSM(f32x16& p0, f32x16& p1, float& m_reg, float& mn, float& alpha, const float C, const float thr) {
  float pmax = p0[0];
#pragma unroll
  for (int r = 1; r < 16; ++r) pmax = fmaxf(pmax, p0[r]);
#pragma unroll
  for (int r = 0; r < 16; ++r) pmax = fmaxf(pmax, p1[r]);
  { auto rr = __builtin_amdgcn_permlane32_swap(__float_as_uint(pmax), __float_as_uint(pmax), false, false);
    pmax = fmaxf(__uint_as_float(rr[0]), __uint_as_float(rr[1])); }
  if (__builtin_expect(__all(pmax - m_reg <= thr), 1)) { mn = m_reg; alpha = 1.f; }
  else { mn = fmaxf(m_reg, pmax); alpha = __builtin_amdgcn_exp2f((m_reg - mn) * C); m_reg = mn; }
  const float mnC = -mn * C;
#pragma unroll
  for (int r = 0; r < 16; ++r) p0[r] = fmaf(p0[r], C, mnC);
#pragma unroll
  for (int r = 0; r < 16; ++r) p1[r] = fmaf(p1[r], C, mnC);
#pragma unroll
  for (int r = 0; r < 16; ++r) p0[r] = __builtin_amdgcn_exp2f(p0[r]);
}
DI void finishSM(f32x16& p0, f32x16& p1, float alpha, float& l_reg, bf16x8& pa0, bf16x8& pa1, bf16x8& pa2, bf16x8& pa3) {
#pragma unroll
  for (int r = 0; r < 16; ++r) p1[r] = __builtin_amdgcn_exp2f(p1[r]);
  float ps = 0;
#pragma unroll
  for (int r = 0; r < 16; ++r) ps += p0[r];
#pragma unroll
  for (int r = 0; r < 16; ++r) ps += p1[r];
  { auto rr = __builtin_amdgcn_permlane32_swap(__float_as_uint(ps), __float_as_uint(ps), false, false);
    ps = __uint_as_float(rr[0]) + __uint_as_float(rr[1]); }
  l_reg = l_reg * alpha + ps;
#define PK4(P, BASE, OUT) do { unsigned a0 = cvtpk(P[BASE + 0], P[BASE + 1]), a1 = cvtpk(P[BASE + 2], P[BASE + 3]);   \
    unsigned b0 = cvtpk(P[BASE + 4], P[BASE + 5]), b1 = cvtpk(P[BASE + 6], P[BASE + 7]);                              \
    auto r0 = __builtin_amdgcn_permlane32_swap(a0, b0, false, false); auto r1 = __builtin_amdgcn_permlane32_swap(a1, b1, false, false); \
    u32x4 w = {r0[0], r1[0], r0[1], r1[1]}; OUT = *reinterpret_cast<bf16x8*>(&w); } while (0)
  PK4(p0, 0, pa0); PK4(p0, 8, pa1); PK4(p1, 0, pa2); PK4(p1, 8, pa3);
#undef PK4
}
template <int NDK>
DI void qkt(f32x16& p0, f32x16& p1, const char* Ks, const bf16x8* qr, int r32, int hi) {
  p0 = f32x16{}; p1 = f32x16{};
#pragma unroll
  for (int d0 = 0; d0 < NDK; ++d0) { const int cb = (d0 * 16 + hi * 8) * 2;
    bf16x8 b0 = *reinterpret_cast<const bf16x8*>(Ks + KSWZ(r32, cb));
    bf16x8 b1 = *reinterpret_cast<const bf16x8*>(Ks + KSWZ(32 + r32, cb));
    p0 = MFMA32(b0, qr[d0], p0);
    p1 = MFMA32(b1, qr[d0], p1); }
}
DI int v_st(int k, int c) { const int kk = (k & ~0xC) | ((k & 4) << 1) | ((k & 8) >> 1); return ((kk >> 3) * 4 + (c >> 5)) * 512 + ((kk & 7) * 32 + (c & 31)) * 2; }
DI int v_rd_base(int lane) { return ((lane & 3) << 3) | (((lane >> 2) & 3) << 6) | (((lane >> 4) & 1) << 5) | (((lane >> 5) & 1) << 8); }
constexpr int v_rd_off(int d0, int ks, int half) { return d0 * 512 + ks * 4096 + half * 2048; }
template <int OFF> DI s16x4 tr_read(int vb) {
  s16x4 r; asm volatile("ds_read_b64_tr_b16 %0, %1 offset:%2" : "=&v"(r) : "v"(vb), "i"(OFF) : "memory"); return r;
}
template <int D0> DI void pv_one(f32x16& od, int vb, bf16x8 pa0, bf16x8 pa1, bf16x8 pa2, bf16x8 pa3) {
  const s16x4 l0 = tr_read<v_rd_off(D0, 0, 0)>(vb), h0 = tr_read<v_rd_off(D0, 0, 1)>(vb), l1 = tr_read<v_rd_off(D0, 1, 0)>(vb), h1 = tr_read<v_rd_off(D0, 1, 1)>(vb);
  const s16x4 l2 = tr_read<v_rd_off(D0, 2, 0)>(vb), h2 = tr_read<v_rd_off(D0, 2, 1)>(vb), l3 = tr_read<v_rd_off(D0, 3, 0)>(vb), h3 = tr_read<v_rd_off(D0, 3, 1)>(vb);
  asm volatile("s_waitcnt lgkmcnt(0)" ::: "memory"); SBAR();
#define PK(L, H) (bf16x8){L[0], L[1], L[2], L[3], H[0], H[1], H[2], H[3]}
  od = MFMA32(pa0, PK(l0, h0), od);
  od = MFMA32(pa1, PK(l1, h1), od);
  od = MFMA32(pa2, PK(l2, h2), od);
  od = MFMA32(pa3, PK(l3, h3), od);
#undef PK
}
DI void pv_d0(f32x16* o, int vb, bf16x8 pa0, bf16x8 pa1, bf16x8 pa2, bf16x8 pa3) {
  pv_one<0>(o[0], vb, pa0, pa1, pa2, pa3); pv_one<1>(o[1], vb, pa0, pa1, pa2, pa3); pv_one<2>(o[2], vb, pa0, pa1, pa2, pa3); pv_one<3>(o[3], vb, pa0, pa1, pa2, pa3);
}

template <int NDK>
DI void attn_item(const bf16_t* __restrict__ Qb, long ldq, const bf16_t* __restrict__ K0, long ldk0, const bf16_t* __restrict__ K1, long ldk1,
                  const bf16_t* __restrict__ Vh, long ldv, bf16_t* __restrict__ Ob, long ldo, int seq, const float C, const float thr) {
  char* lds = smem;
  __syncthreads();
  const int tid = otid(), wid = tid >> 6, lane = tid & 63, r32 = lane & 31, hi = lane >> 5;
  char* V_lds = lds; char* K_lds = lds + 2 * SHM_V;
  float* wsb = (float*)(lds + 2 * SHM_V + 2 * SHM_K) + wid * 64; float* li_l = wsb; float* al_l = wsb + 32;
  float m_reg = -1e30f, l_reg = 0; f32x16 o[4] = {}; bf16x8 qr[NDK];
  const bf16_t* Qw = Qb + (long)(wid * QBLK + r32) * ldq + hi * 8;
#pragma unroll
  for (int d0 = 0; d0 < NDK; ++d0) qr[d0] = ld8(Qw + d0 * 16);
  const int sr = tid >> 4, sc = (tid & 15) * 8, vst0 = v_st(sr, sc), vst1 = v_st(32 + sr, sc);
  const bf16_t* kp; long kld;
  if (NDK == 8 || sc < 64) { kp = K0 + sc; kld = ldk0; } else { kp = K1 + ((sc - 64) & 31); kld = ldk1; }
  const bf16_t* vp = Vh + sc;
  const int vb0 = (int)(uintptr_t)V_lds + v_rd_base(lane);
  struct { bf16x8 vs0, vs1, ks0, ks1; } sr_[2];
#define SLOAD(i, k0) do { sr_[i].vs0 = ld8(vp + (long)((k0) + sr) * ldv); sr_[i].vs1 = ld8(vp + (long)((k0) + 32 + sr) * ldv); \
    sr_[i].ks0 = ld8(kp + (long)((k0) + sr) * kld); sr_[i].ks1 = ld8(kp + (long)((k0) + 32 + sr) * kld); } while (0)
#define SWRITE(b, i) do { *(bf16x8*)(V_lds + (b) * SHM_V + vst0) = sr_[i].vs0;          \
    *(bf16x8*)(V_lds + (b) * SHM_V + vst1) = sr_[i].vs1; int kc = sc * 2;               \
    *(bf16x8*)(K_lds + (b) * SHM_K + KSWZ(sr, kc)) = sr_[i].ks0;                       \
    *(bf16x8*)(K_lds + (b) * SHM_K + KSWZ(32 + sr, kc)) = sr_[i].ks1; } while (0)
#define SWAIT() asm volatile("s_waitcnt vmcnt(4)" ::: "memory")
#define RESC(a) do { if (__any((a) < 1.f)) { if (hi == 0) al_l[r32] = (a); asm volatile("s_waitcnt lgkmcnt(0)" ::: "memory"); \
    for (int d = 0; d < 4; ++d) for (int r = 0; r < 16; ++r) o[d][r] *= al_l[crow(r, hi)]; } } while (0)
  f32x16 pA0, pA1, pB0, pB1; float mnA, mnB, alA, alB; bf16x8 pa0, pa1, pa2, pa3; const int NT = seq / KVBLK;
  constexpr int SE = 0, SO = 1;
  SLOAD(SE, 0); asm volatile("s_waitcnt vmcnt(0)" ::: "memory"); SWRITE(0, SE); __syncthreads();
  qkt<NDK>(pA0, pA1, K_lds, qr, r32, hi); partialSM(pA0, pA1, m_reg, mnA, alA, C, thr);
  SLOAD(SO, KVBLK); if (2 < NT) SLOAD(SE, 2 * KVBLK);
  SWAIT(); SWRITE(1, SO); __syncthreads();
#pragma unroll 1
  for (int j = 1; j + 1 < NT; j += 2) {
    SBAR(); qkt<NDK>(pB0, pB1, K_lds + SHM_K, qr, r32, hi);
    finishSM(pA0, pA1, alA, l_reg, pa0, pa1, pa2, pa3); SBAR();
    SLOAD(SO, (j + 2) * KVBLK); SBAR();
    pv_d0(o, vb0, pa0, pa1, pa2, pa3); partialSM(pB0, pB1, m_reg, mnB, alB, C, thr);
    __syncthreads(); SWAIT(); SWRITE(0, SE);
    RESC(alB); __syncthreads();
    SBAR(); qkt<NDK>(pA0, pA1, K_lds, qr, r32, hi);
    finishSM(pB0, pB1, alB, l_reg, pa0, pa1, pa2, pa3); SBAR();
    if (j + 3 < NT) SLOAD(SE, (j + 3) * KVBLK); SBAR();
    pv_d0(o, vb0 + (int)SHM_V, pa0, pa1, pa2, pa3); partialSM(pA0, pA1, m_reg, mnA, alA, C, thr);
    __syncthreads(); SWAIT(); SWRITE(1, SO);
    RESC(alA); __syncthreads();
  }
  SBAR(); qkt<NDK>(pB0, pB1, K_lds + SHM_K, qr, r32, hi);
  finishSM(pA0, pA1, alA, l_reg, pa0, pa1, pa2, pa3); SBAR();
  pv_d0(o, vb0, pa0, pa1, pa2, pa3); partialSM(pB0, pB1, m_reg, mnB, alB, C, thr);
  __syncthreads(); RESC(alB);
  finishSM(pB0, pB1, alB, l_reg, pa0, pa1, pa2, pa3); SBAR();
  pv_d0(o, vb0 + (int)SHM_V, pa0, pa1, pa2, pa3);
  if (hi == 0) li_l[r32] = l_reg; asm volatile("s_waitcnt lgkmcnt(0)" ::: "memory");
  float rli[16];
#pragma unroll
  for (int r = 0; r < 16; ++r) rli[r] = __builtin_amdgcn_rcpf(li_l[crow(r, hi)]);
  bf16_t* Ow = Ob + (long)(wid * QBLK) * ldo;
#pragma unroll
  for (int r = 0; r < 16; ++r) { const int orow = crow(r, hi);
#pragma unroll
    for (int d0 = 0; d0 < 4; ++d0) Ow[(long)orow * ldo + d0 * 32 + r32] = f2bf(o[d0][r] * rli[r]); }
#undef SLOAD
#undef SWRITE
#undef SWAIT
#undef RESC
}

DI void ret_u_item(int n, int h, const bf16_t* __restrict__ PM, bf16_t* __restrict__ S, float lgf, float lgb) {
  __syncthreads();
  const int tid = otid(), wid = tid >> 6, lane = tid & 63, r32 = lane & 31, hi = lane >> 5;
  bf16_t* Vs = (bf16_t*)smem; bf16_t* Kf = Vs + 128 * 256; bf16_t* Kb = Kf + 128 * 128;
  const long r0 = (long)n * 128;
#pragma unroll
  for (int i = 0; i < 8; ++i) { const int id = tid + 512 * i, tok = id >> 5, c8 = id & 31;
    *(bf16x8*)(Vs + tok * 256 + c8 * 8) = ld8(PM + (r0 + tok) * PW + C_RV + h * 256 + c8 * 8); }
#pragma unroll
  for (int i = 0; i < 4; ++i) { const int id = tid + 512 * i, tok = id >> 4, c8 = id & 15;
    const bf16x8 kv = ld8(PM + (r0 + tok) * PW + C_RK + h * 128 + c8 * 8);
    const float zf = __builtin_amdgcn_exp2f(lgf * (float)(127 - tok)), zb = __builtin_amdgcn_exp2f(lgb * (float)tok);
    u32x4 of, ob;
#pragma unroll
    for (int j = 0; j < 4; ++j) { const float a = bf2f((bf16_t)kv[2 * j]), b = bf2f((bf16_t)kv[2 * j + 1]); of[j] = cvtpk(a * zf, b * zf); ob[j] = cvtpk(a * zb, b * zb); }
    *(u32x4*)(Kf + tok * 128 + c8 * 8) = of; *(u32x4*)(Kb + tok * 128 + c8 * 8) = ob; }
  __syncthreads();
  f32x16 acc[2][4];
#pragma unroll
  for (int d = 0; d < 2; ++d)
#pragma unroll
    for (int b = 0; b < 4; ++b) acc[d][b] = f32x16{};
#pragma unroll 1
  for (int ks = 0; ks < 8; ++ks) {
    const int t0 = ks * 16 + 8 * hi;
    bf16x8 a;
#pragma unroll
    for (int j = 0; j < 8; ++j) a[j] = (short)Vs[(t0 + j) * 256 + wid * 32 + r32];
#pragma unroll
    for (int b = 0; b < 4; ++b) { bf16x8 bf_, bb_;
#pragma unroll
      for (int j = 0; j < 8; ++j) { bf_[j] = (short)Kf[(t0 + j) * 128 + b * 32 + r32]; bb_[j] = (short)Kb[(t0 + j) * 128 + b * 32 + r32]; }
      acc[0][b] = MFMA32(a, bf_, acc[0][b]); acc[1][b] = MFMA32(a, bb_, acc[1][b]); }
  }
#pragma unroll
  for (int d = 0; d < 2; ++d) { bf16_t* Sp = S + ((long)(d * NCH + n) * 4 + h) * 32768;
#pragma unroll
    for (int b = 0; b < 4; ++b)
#pragma unroll
      for (int r = 0; r < 16; ++r) Sp[(wid * 32 + crow(r, hi)) * 128 + b * 32 + r32] = f2bf(acc[d][b][r]); }
}

DI void ret_scan(bf16_t* __restrict__ S, const float* lg2) {
  const int npairs = 2 * 65536;
  const int tid = otid();
  for (int pi = blockIdx.x * 512 + tid; pi < npairs; pi += gridDim.x * 512) {
    const int dir = pi >> 16, e = (pi & 65535) * 2, h = e >> 15;
    const float cd = __builtin_amdgcn_exp2f(lg2[dir * 4 + h] * 128.f);
    unsigned* base = (unsigned*)(S + (long)dir * NCH * 131072 + e);
    float s0 = 0.f, s1 = 0.f;
#pragma unroll 1
    for (int st0 = 0; st0 < NCH; st0 += 10) {
      unsigned u[10];
#pragma unroll
      for (int q = 0; q < 10; ++q) { const int st = st0 + q; const int n = dir == 0 ? st : (st == 0 ? 1 : (st == 1 ? 0 : 131 - st)); u[q] = base[(long)n * 65536]; }
#pragma unroll
      for (int q = 0; q < 10; ++q) { const int st = st0 + q; const int n = dir == 0 ? st : (st == 0 ? 1 : (st == 1 ? 0 : 131 - st));
        base[(long)n * 65536] = cvtpk(s0, s1);
        s0 = cd * s0 + __uint_as_float(u[q] << 16); s1 = cd * s1 + __uint_as_float(u[q] & 0xffff0000u); }
    }
  }
}

DI void ret_out_item(int n, int h, bf16_t* __restrict__ PM, const bf16_t* __restrict__ S, float lgf, float lgb) {
  __syncthreads();
  const int tid = otid(), wid = tid >> 6, lane = tid & 63, r32 = lane & 31, hi = lane >> 5;
  char* Qs = smem; bf16_t* Vs = (bf16_t*)(smem + 32768); char* Ks = smem + 98304; bf16_t* Yb = (bf16_t*)(smem + 98304);
  const long r0 = (long)n * 128;
#pragma unroll
  for (int i = 0; i < 8; ++i) { const int id = tid + 512 * i, tok = id >> 5, c8 = id & 31;
    *(bf16x8*)(Vs + tok * 256 + c8 * 8) = ld8(PM + (r0 + tok) * PW + C_RV + h * 256 + c8 * 8); }
#pragma unroll
  for (int i = 0; i < 4; ++i) { const int id = tid + 512 * i, tok = id >> 4, c8 = id & 15;
    *(bf16x8*)(Qs + KSWZ(tok, c8 * 16)) = ld8(PM + (r0 + tok) * PW + C_RQ + h * 128 + c8 * 8);
    *(bf16x8*)(Ks + KSWZ(tok, c8 * 16)) = ld8(PM + (r0 + tok) * PW + C_RK + h * 128 + c8 * 8); }
  __syncthreads();
  const int qb = wid & 3, dh = wid >> 2;
  const int qi = qb * 32 + r32;
  bf16x8 pf[4][2];
#pragma unroll
  for (int kb = 0; kb < 4; ++kb) { f32x16 pt = f32x16{};
#pragma unroll 2
    for (int ks = 0; ks < 8; ++ks) { const int cb = (ks * 16 + hi * 8) * 2;
      const bf16x8 kf = *(const bf16x8*)(Ks + KSWZ(kb * 32 + r32, cb)); const bf16x8 qf = *(const bf16x8*)(Qs + KSWZ(qi, cb)); pt = MFMA32(kf, qf, pt); }
#pragma unroll
    for (int r = 0; r < 16; ++r) { const int kj = kb * 32 + crow(r, hi); const float d = (float)(qi - kj);
      float w = 0.f; if (qi >= kj) w += __builtin_amdgcn_exp2f(lgf * d); if (kj >= qi) w += __builtin_amdgcn_exp2f(-lgb * d);
      pt[r] *= w; }
#pragma unroll
    for (int s = 0; s < 2; ++s) { u32x4 w = {cvtpk(pt[8 * s], pt[8 * s + 1]), cvtpk(pt[8 * s + 2], pt[8 * s + 3]), cvtpk(pt[8 * s + 4], pt[8 * s + 5]), cvtpk(pt[8 * s + 6], pt[8 * s + 7])};
      pf[kb][s] = *reinterpret_cast<bf16x8*>(&w); } }
  __syncthreads();
  const float xf = __builtin_amdgcn_exp2f(lgf * (float)(qi + 1)), xb = __builtin_amdgcn_exp2f(lgb * (float)(128 - qi));
  const bf16_t* Sf = S + ((long)(0 * NCH + n) * 4 + h) * 32768; const bf16_t* Sb = S + ((long)(1 * NCH + n) * 4 + h) * 32768;
#pragma unroll 1
  for (int d = 0; d < 4; ++d) { const int dvb = (dh * 4 + d) * 32; const int dv = dvb + r32;
    f32x16 a1 = f32x16{}, a2 = f32x16{};
#pragma unroll 2
    for (int ks = 0; ks < 8; ++ks) { const bf16x8 qf = *(const bf16x8*)(Qs + KSWZ(qi, (ks * 16 + hi * 8) * 2));
      a1 = MFMA32(ld8(Sf + dv * 128 + ks * 16 + hi * 8), qf, a1); a2 = MFMA32(ld8(Sb + dv * 128 + ks * 16 + hi * 8), qf, a2); }
#pragma unroll
    for (int r = 0; r < 16; ++r) a1[r] = a1[r] * xf + a2[r] * xb;
#pragma unroll
    for (int kb = 0; kb < 4; ++kb)
#pragma unroll
      for (int s = 0; s < 2; ++s) { bf16x8 a; const bf16_t* vb = Vs + (kb * 32 + 16 * s + 4 * hi) * 256 + dv;
#pragma unroll
        for (int j = 0; j < 8; ++j) a[j] = (short)vb[((j & 3) + 8 * (j >> 2)) * 256];
        a1 = MFMA32(a, pf[kb][s], a1); }
#pragma unroll
    for (int r = 0; r < 16; ++r) Yb[qi * 256 + ((dvb + crow(r, hi)) ^ r32)] = f2bf(a1[r]); }
  __syncthreads();
  { const int i = tid >> 2, qd = tid & 3; const bf16_t* yr = Yb + i * 256; const int sw = i & 31;
    float ss = 0.f;
#pragma unroll 8
    for (int c = 0; c < 64; ++c) { const float v = bf2f(yr[(qd * 64 + c) ^ sw]); ss += v * v; }
    ss += __shfl_xor(ss, 1); ss += __shfl_xor(ss, 2);
    const float rn = rsqrtf(ss * (1.f / 256.f) + 1e-6f);
    bf16_t* gp = PM + (r0 + i) * PW + C_RG + h * 256 + qd * 64;
#pragma unroll 1
    for (int c8 = 0; c8 < 8; ++c8) { const bf16x8 g = ld8(gp + c8 * 8); float o[8];
#pragma unroll
      for (int j = 0; j < 8; ++j) { const float gv = bf2f((bf16_t)g[j]); o[j] = gv * sigm(gv) * bf2f(yr[(qd * 64 + c8 * 8 + j) ^ sw]) * rn; }
      u32x4 w = {cvtpk(o[0], o[1]), cvtpk(o[2], o[3]), cvtpk(o[4], o[5]), cvtpk(o[6], o[7])}; *(u32x4*)(gp + c8 * 8) = w; } }
}

DI void conv_w(const float* __restrict__ W, bf16_t* __restrict__ Wt, int K, int N, int mode) {
  float* ldsf = (float*)smem; const int tid = otid(); const int nnt = N / 32, nt = nnt * (K / 128);
  for (int t0 = blockIdx.x * 4; t0 < nt; t0 += gridDim.x * 4) {
    __syncthreads();
    { const int n = tid & 31, kk = tid >> 5; float v[4][8];
#pragma unroll
      for (int q = 0; q < 4; ++q) { const int t = t0 + q; const int n0 = (t % nnt) * 32, k0 = (t / nnt) * 128;
#pragma unroll
        for (int i = 0; i < 8; ++i) v[q][i] = t < nt ? W[(long)(k0 + kk + 16 * i) * N + n0 + n] : 0.f; }
#pragma unroll
      for (int q = 0; q < 4; ++q)
#pragma unroll
        for (int i = 0; i < 8; ++i) ldsf[q * 4160 + n * 129 + kk + 16 * i] = v[q][i]; }
    __syncthreads();
#pragma unroll
    for (int q = 0; q < 4; ++q) { const int t = t0 + q; if (t < nt) { const int n0 = (t % nnt) * 32, k0 = (t / nnt) * 128;
      const int n = tid >> 4, k8 = (tid & 15) * 8; const float* s = ldsf + q * 4160 + n * 129 + k8; const int sn = n0 + n; int dn = sn;
      if (mode == 1) dn = sn < NMAIN ? sn : sn + (GATE_ROW0 - NMAIN);
      if (mode == 2) dn = sn < FH ? ((sn >> 7) * 256 + (sn & 127)) : ((((sn - FH) >> 7) * 256) + 128 + ((sn - FH) & 127));
      u32x4 o = {cvtpk(s[0], s[1]), cvtpk(s[2], s[3]), cvtpk(s[4], s[5]), cvtpk(s[6], s[7])};
      *(u32x4*)(Wt + (long)dn * K + k0 + k8) = o; } }
  }
}
DI void conv_layer(const Params& p, int l) {
  unsigned char* ws = p.ws;
  conv_w(p.w_in + (size_t)l * 1024 * 8224, (bf16_t*)(ws + O_WIN), 1024, 8224, 1);
  { u32x4 z = {0u, 0u, 0u, 0u}; u32x4* zp = (u32x4*)((bf16_t*)(ws + O_WIN) + (size_t)NMAIN * 1024);
    for (int i = blockIdx.x * 512 + otid(); i < (GATE_ROW0 - NMAIN) * 1024 / 8; i += gridDim.x * 512) zp[i] = z; }
  conv_w(p.w_mla_qb + (size_t)l * 256 * 768, (bf16_t*)(ws + O_QB), 256, 768, 0);
  conv_w(p.w_mla_kvb + (size_t)l * 256 * 1536, (bf16_t*)(ws + O_KVB), 256, 1536, 0);
  conv_w(p.w_ret_o + (size_t)l * 1024 * 1024, (bf16_t*)(ws + O_RO), 1024, 1024, 0);
  conv_w(p.w_mla_o + (size_t)l * 1024 * 1024, (bf16_t*)(ws + O_MO), 1024, 1024, 0);
  conv_w(p.w_gqa_o + (size_t)l * 1024 * 1024, (bf16_t*)(ws + O_GO), 1024, 1024, 0);
  conv_w(p.w_out + (size_t)l * 1024 * 1024, (bf16_t*)(ws + O_WO), 1024, 1024, 0);
  conv_w(p.w_ffn_in + (size_t)l * 1024 * 5632, (bf16_t*)(ws + O_FI), 1024, 5632, 2);
  conv_w(p.w_ffn_out + (size_t)l * FH * 1024, (bf16_t*)(ws + O_FO), FH, 1024, 0);
}

DI void norm_mod(const float* __restrict__ X, bf16_t* __restrict__ H, const float* __restrict__ g, const float* __restrict__ mods, int ishift, int iscale) {
  const int tid_ = otid(); const int wid = tid_ >> 6, lane = tid_ & 63;
  for (int row = blockIdx.x * 8 + wid; row < MR; row += gridDim.x * 8) {
    const float* xr = X + (long)row * 1024; const float* mv = mods + (row < CTXN ? 6144 : 0);
    f32x4 v[4]; float ss = 0.f;
#pragma unroll
    for (int i = 0; i < 4; ++i) { v[i] = *(const f32x4*)(xr + i * 256 + lane * 4); ss += v[i][0] * v[i][0] + v[i][1] * v[i][1] + v[i][2] * v[i][2] + v[i][3] * v[i][3]; }
    ss = wsum(ss); const float rn = rsqrtf(ss * (1.f / 1024.f) + 1e-6f);
#pragma unroll
    for (int i = 0; i < 4; ++i) { const int c = i * 256 + lane * 4; const f32x4 gg = *(const f32x4*)(g + c), sh = *(const f32x4*)(mv + ishift * 1024 + c), sl = *(const f32x4*)(mv + iscale * 1024 + c);
      float o[4];
#pragma unroll
      for (int j = 0; j < 4; ++j) o[j] = v[i][j] * rn * gg[j] * (1.f + sl[j]) + sh[j];
      u32x2 w = {cvtpk(o[0], o[1]), cvtpk(o[2], o[3])}; *(u32x2*)(H + (long)row * 1024 + c) = w; }
  }
}

DI void feat_pass(bf16_t* __restrict__ PM, const float* __restrict__ T128, const float* __restrict__ T32, const float* __restrict__ gq, const float* __restrict__ gkv,
                  const float* __restrict__ ggq, const float* __restrict__ ggk) {
  const int tid_ = otid(); const int wid = tid_ >> 6, lane = tid_ & 63;
  const int half = lane >> 5, j = lane & 31;
  for (int row = blockIdx.x * 8 + wid; row < MR; row += gridDim.x * 8) {
    bf16_t* pr = PM + (long)row * PW; const bool lat = row >= CTXN; const int t = row - CTXN; const int rp = lat ? (t >> 6) : 0, cp = lat ? (t & 63) : 0;
    const int pos = half ? cp : rp;
    float cs = 1.f, sn = 0.f; if (lat) { cs = T128[(pos * 32 + j) * 2]; sn = T128[(pos * 32 + j) * 2 + 1]; }
#pragma unroll
    for (int blk = 0; blk < 8; ++blk) { const int c1 = blk * 128 + half * 64 + j, c2 = c1 + 32; const float x1 = bf2f(pr[c1]), x2 = bf2f(pr[c2]);
      const float sc = blk >= 4 ? 0.08838834764831845f : 1.f;
      pr[c1] = f2bf((x1 * cs - x2 * sn) * sc); pr[c2] = f2bf((x2 * cs + x1 * sn) * sc); }
    { const u32x2 a = *(const u32x2*)(pr + C_CQ + lane * 4); float v[4] = {__uint_as_float(a[0] << 16), __uint_as_float(a[0] & 0xffff0000u), __uint_as_float(a[1] << 16), __uint_as_float(a[1] & 0xffff0000u)};
      float ss = wsum(v[0] * v[0] + v[1] * v[1] + v[2] * v[2] + v[3] * v[3]); const float rn = rsqrtf(ss * (1.f / 256.f) + 1e-6f); const f32x4 g = *(const f32x4*)(gq + lane * 4);
      u32x2 w = {cvtpk(v[0] * rn * g[0], v[1] * rn * g[1]), cvtpk(v[2] * rn * g[2], v[3] * rn * g[3])}; *(u32x2*)(pr + C_CQ + lane * 4) = w; }
    { const u32x2 a = *(const u32x2*)(pr + C_CKV + lane * 4); float v[4] = {__uint_as_float(a[0] << 16), __uint_as_float(a[0] & 0xffff0000u), __uint_as_float(a[1] << 16), __uint_as_float(a[1] & 0xffff0000u)};
      float ss = wsum(v[0] * v[0] + v[1] * v[1] + v[2] * v[2] + v[3] * v[3]); const float rn = rsqrtf(ss * (1.f / 256.f) + 1e-6f); const f32x4 g = *(const f32x4*)(gkv + lane * 4);
      u32x2 w = {cvtpk(v[0] * rn * g[0], v[1] * rn * g[1]), cvtpk(v[2] * rn * g[2], v[3] * rn * g[3])}; *(u32x2*)(pr + C_CKV + lane * 4) = w; }
    if (lat && lane < 16) { const int pi = lane, hh = pi >> 3, jj = pi & 7, c1 = C_KR + hh * 16 + jj, c2 = c1 + 8; const int ps = hh ? cp : rp;
      const float c_ = T32[(ps * 8 + jj) * 2], s_ = T32[(ps * 8 + jj) * 2 + 1]; const float x1 = bf2f(pr[c1]), x2 = bf2f(pr[c2]);
      pr[c1] = f2bf(x1 * c_ - x2 * s_); pr[c2] = f2bf(x2 * c_ + x1 * s_); }
#pragma unroll 1
    for (int hd = 0; hd < 10; ++hd) { const int base = hd < 8 ? C_GQ + hd * 128 : C_GK + (hd - 8) * 128; const float* gg = hd < 8 ? ggq : ggk;
      const int c1 = base + half * 64 + j, c2 = c1 + 32; const float x1 = bf2f(pr[c1]), x2 = bf2f(pr[c2]);
      const float ss = wsum(x1 * x1 + x2 * x2); const float rn = rsqrtf(ss * (1.f / 128.f) + 1e-6f);
      const float y1 = x1 * rn * gg[half * 64 + j], y2 = x2 * rn * gg[half * 64 + j + 32];
      pr[c1] = f2bf(y1 * cs - y2 * sn); pr[c2] = f2bf(y2 * cs + y1 * sn); }
  }
}

DI void mq_rope(bf16_t* __restrict__ MQ, const float* __restrict__ T32) {
  const int tid_ = otid(); const int wid = tid_ >> 6, lane = tid_ & 63;
  for (int row = CTXN + blockIdx.x * 8 + wid; row < MR; row += gridDim.x * 8) {
    const int t = row - CTXN, rp = t >> 6, cp = t & 63; bf16_t* pr = MQ + (long)row * 768;
#pragma unroll
    for (int i = 0; i < 2; ++i) { const int pp = lane + 64 * i, h = pp >> 4, pi = pp & 15, hh = pi >> 3, jj = pi & 7; const int c1 = h * 96 + 64 + hh * 16 + jj, c2 = c1 + 8; const int ps = hh ? cp : rp;
      const float c_ = T32[(ps * 8 + jj) * 2], s_ = T32[(ps * 8 + jj) * 2 + 1]; const float x1 = bf2f(pr[c1]), x2 = bf2f(pr[c2]);
      pr[c1] = f2bf(x1 * c_ - x2 * s_); pr[c2] = f2bf(x2 * c_ + x1 * s_); }
  }
}

DI void phase0(const Params& p) {
  unsigned char* ws = p.ws; const int tid = otid(); const long gt = (long)blockIdx.x * 512 + tid, gn = (long)gridDim.x * 512;
  { f32x4* X4 = (f32x4*)(ws + O_X); const f32x4* c4 = (const f32x4*)p.ctx; const f32x4* x4 = (const f32x4*)p.x;
    for (long i = gt; i < (long)MR * 256; i += gn) X4[i] = i < 65536 ? c4[i] : x4[i - 65536]; }
  { float* T128 = (float*)(ws + O_T128); float* T32 = (float*)(ws + O_T32);
    for (long i = gt; i < 256 * 32 + 256 * 8; i += gn) { int pos, jj; float inv; float* dst;
      if (i < 256 * 32) { pos = (int)i >> 5; jj = (int)i & 31; inv = powf(10000.f, -(float)jj / 32.f); dst = T128 + i * 2; }
      else { const int q = (int)i - 256 * 32; pos = q >> 3; jj = q & 7; inv = powf(10000.f, -(float)jj / 8.f); dst = T32 + (long)q * 2; }
      const float ang = (float)pos * inv; const float k = rintf(ang * 0.15915494309189535f);
      float r = fmaf(-k, 6.28318548202514648f, ang); r = fmaf(-k, -1.74845553e-07f, r);
      dst[0] = cosf(r); dst[1] = sinf(r); } }
  { float* sl = (float*)smem; float* red = sl + 2048; float* mods = (float*)(ws + O_MODS);
    for (int item = blockIdx.x; item < DEPTH * 48; item += gridDim.x) { const int l = item / 48, cg0 = (item % 48) * 128;
      __syncthreads();
      for (int k = tid; k < 1024; k += 512) { const float a = p.c[k], b = p.c_ctx[k]; sl[k] = a * sigm(a); sl[1024 + k] = b * sigm(b); }
      __syncthreads();
      const int col = tid & 127, ks = tid >> 7; const float* w = p.w_mod + ((size_t)l * 1024 + ks * 256) * 6144 + cg0 + col;
      float a0 = 0.f, a1 = 0.f;
#pragma unroll 8
      for (int k = 0; k < 256; ++k) { const float wv = w[(size_t)k * 6144]; a0 = fmaf(sl[ks * 256 + k], wv, a0); a1 = fmaf(sl[1024 + ks * 256 + k], wv, a1); }
      red[(ks * 128 + col) * 2] = a0; red[(ks * 128 + col) * 2 + 1] = a1;
      __syncthreads();
      if (tid < 256) { const int cc = tid & 127, which = tid >> 7; float s = 0.f;
        for (int q = 0; q < 4; ++q) s += red[(q * 128 + cc) * 2 + which];
        mods[((size_t)l * 2 + which) * 6144 + cg0 + cc] = s + p.b_mod[(size_t)l * 6144 + cg0 + cc]; } } }
}

DI void final_norm(const float* __restrict__ X, const float* __restrict__ g, float* __restrict__ out) {
  const int tid_ = otid(); const int wid = tid_ >> 6, lane = tid_ & 63;
  for (int t = blockIdx.x * 8 + wid; t < SEQL; t += gridDim.x * 8) {
    const float* xr = X + (long)(CTXN + t) * 1024; f32x4 v[4]; float ss = 0.f;
#pragma unroll
    for (int i = 0; i < 4; ++i) { v[i] = *(const f32x4*)(xr + i * 256 + lane * 4); ss += v[i][0] * v[i][0] + v[i][1] * v[i][1] + v[i][2] * v[i][2] + v[i][3] * v[i][3]; }
    ss = wsum(ss); const float rn = rsqrtf(ss * (1.f / 1024.f) + 1e-6f);
#pragma unroll
    for (int i = 0; i < 4; ++i) { const int c = i * 256 + lane * 4; const f32x4 gg = *(const f32x4*)(g + c); *(f32x4*)(out + (long)t * 1024 + c) = v[i] * rn * gg; }
  }
}

#define WSP(T, off) ((T*)(ws + (off)))
#define PHASE_BEGIN const Params& p = kargs(); unsigned char* ws = p.ws;
__global__ void __launch_bounds__(512) mega(Params p_unused) {
  cg::grid_group grid = cg::this_grid();
  constexpr int NM = MR / 256;
  const float LOG2E = 1.4426950408889634f;
  const float mlaC = 0.10206207261596577f * LOG2E, mlaT = 8.f / 0.10206207261596577f, gqaC = 0.08838834764831845f * LOG2E, gqaT = 8.f / 0.08838834764831845f;

  { const Params& p = kargs(); phase0(p); }
  { const Params& p = kargs(); conv_layer(p, 0); }
  grid.sync();
#pragma unroll 1
  for (int l = 0; l < DEPTH; ++l) {
    const bool need_ctx = l < DEPTH - 1;
    { PHASE_BEGIN
    if (l > 0) conv_layer(kargs(), l);
    norm_mod(WSP(float, O_X), WSP(bf16_t, O_H), p.g_mix + l * 1024, WSP(float, O_MODS) + (size_t)l * 2 * 6144, 0, 1);
    }
    grid.sync();
    { PHASE_BEGIN
    gemm_phase<false>(WSP(bf16_t, O_H), 1024, WSP(bf16_t, O_WIN), 1024, 1024, NM, PW / 256, EpiStore{WSP(bf16_t, O_PM), PW, 0});
    }
    grid.sync();
    { PHASE_BEGIN
    feat_pass(WSP(bf16_t, O_PM), WSP(float, O_T128), WSP(float, O_T32), p.g_mla_q + l * 256, p.g_mla_kv + l * 256, p.g_gqa_q + l * 128, p.g_gqa_k + l * 128);
    }
    grid.sync();
    { PHASE_BEGIN
    gemm_phase<false>(WSP(bf16_t, O_PM) + C_CQ, PW, WSP(bf16_t, O_QB), 256, 256, NM, 3, EpiStore{WSP(bf16_t, O_MQ), 768, 0});
    gemm_phase<false>(WSP(bf16_t, O_PM) + C_CKV, PW, WSP(bf16_t, O_KVB), 256, 256, NM, 6, EpiStore{WSP(bf16_t, O_MKV), 1536, 0});
#pragma unroll 1
    for (int it = blockIdx.x; it < NCH * 4; it += gridDim.x) ret_u_item(it >> 2, it & 3, WSP(bf16_t, O_PM), WSP(bf16_t, O_S), p.lg2[it & 3], p.lg2[4 + (it & 3)]);
    }
    grid.sync();
    { PHASE_BEGIN
    mq_rope(WSP(bf16_t, O_MQ), WSP(float, O_T32));
    ret_scan(WSP(bf16_t, O_S), p.lg2);
    }
    grid.sync();
    { PHASE_BEGIN
    { bf16_t* PM = WSP(bf16_t, O_PM);
      const int nlat = 512, nctx = need_ctx ? 8 : 0;
#pragma unroll 1
      for (int it = blockIdx.x; it < nlat + nctx; it += gridDim.x) { const int hd = it & 7, qb = it >> 3; const bool isc = it >= nlat;
        const long q0 = (isc ? 0 : (long)(CTXN + qb * 256) * PW) + C_GQ + hd * 128;
        attn_item<8>(PM + q0, PW, PM + C_GK + (hd >> 2) * 128, PW, PM, 0, PM + C_GV + (hd >> 2) * 128, PW, PM + q0, PW, isc ? CTXN : MR, gqaC, gqaT); }
      const int n0 = need_ctx ? 0 : 2;
#pragma unroll 1
      for (int it = blockIdx.x; it < (NCH - n0) * 4; it += gridDim.x) { const int n = n0 + (it >> 2), h = it & 3; ret_out_item(n, h, PM, WSP(bf16_t, O_S), p.lg2[h], p.lg2[4 + h]); } }
    }
    grid.sync();
    { PHASE_BEGIN
    { bf16_t* PM = WSP(bf16_t, O_PM); const bf16_t* MQ = WSP(bf16_t, O_MQ); const bf16_t* MKV = WSP(bf16_t, O_MKV);
#pragma unroll 1
      for (int it = blockIdx.x; it < 512 + (need_ctx ? 8 : 0); it += gridDim.x) {
        const int hd = it & 7; const bool isc = it >= 512; const int qb = it >> 3; const long rq = isc ? 0 : (long)(CTXN + qb * 256);
        attn_item<6>(MQ + rq * 768 + hd * 96, 768, MKV + hd * 192, 1536, PM + C_KR, PW, MKV + hd * 192 + 64, 1536, PM + rq * PW + C_RQ + hd * 128, PW, isc ? CTXN : MR, mlaC, mlaT); } }
    }
    grid.sync();
    { PHASE_BEGIN
    gemm_phase<false>(WSP(bf16_t, O_H), 1024, WSP(bf16_t, O_WIN) + (size_t)GATE_ROW0 * 1024, 1024, 1024, NM - 1, 12, EpiStore{WSP(bf16_t, O_GATES), 3072, 1}, 1);
    if (need_ctx) { const int tid = otid(); bf16_t* G = WSP(bf16_t, O_GATES);
#pragma unroll 1
      for (int it = blockIdx.x; it < 8 * 96; it += gridDim.x) { const int rt = it / 96, ct = it - rt * 96; float o[2];
        ctx_tile(WSP(bf16_t, O_H), 1024, WSP(bf16_t, O_WIN) + (size_t)GATE_ROW0 * 1024, 1024, 1024, rt * 32, ct * 32, o);
#pragma unroll
        for (int s = 0; s < 2; ++s) { const int e = tid + 512 * s; G[(long)(rt * 32 + (e >> 5)) * 3072 + ct * 32 + (e & 31)] = f2bf(sigm(o[s])); } } }
    }
    grid.sync();
    { PHASE_BEGIN
    gemm_phase<true>(WSP(bf16_t, O_PM), PW, WSP(bf16_t, O_RO), 1024, 1024, NM - 1, 4, EpiMerge{WSP(float, O_ZF), WSP(bf16_t, O_GATES), WSP(bf16_t, O_PM) + C_RV, PW}, 1);
    if (need_ctx) { const int tid = otid(); bf16_t* PM = WSP(bf16_t, O_PM); const bf16_t* G = WSP(bf16_t, O_GATES);
#pragma unroll 1
      for (int it = blockIdx.x; it < 8 * 32; it += gridDim.x) { const int rt = it >> 5, ct = it & 31; float z[2] = {0.f, 0.f};
#pragma unroll 1
        for (int b = 0; b < 3; ++b) { float o[2];
          ctx_tile(PM + (b == 0 ? C_RG : (b == 1 ? C_RQ : C_GQ)), PW, WSP(bf16_t, O_RO) + (size_t)b * 1024 * 1024, 1024, 1024, rt * 32, ct * 32, o);
#pragma unroll
          for (int s = 0; s < 2; ++s) { const int e = tid + 512 * s; z[s] += o[s] * bf2f(G[(long)(rt * 32 + (e >> 5)) * 3072 + b * 1024 + ct * 32 + (e & 31)]); } }
#pragma unroll
        for (int s = 0; s < 2; ++s) { const int e = tid + 512 * s; PM[(long)(rt * 32 + (e >> 5)) * PW + C_RV + ct * 32 + (e & 31)] = f2bf(z[s]); } } }
    }
    grid.sync();
    { PHASE_BEGIN
    gemm_phase<false>(WSP(bf16_t, O_PM) + C_RV, PW, WSP(bf16_t, O_WO), 1024, 1024, NM - 1, 4, EpiResid{WSP(float, O_X), WSP(float, O_MODS) + (size_t)l * 2 * 6144, 2}, 1);
    if (need_ctx) { const int tid = otid(); float* X = WSP(float, O_X); const float* mv = WSP(float, O_MODS) + (size_t)l * 2 * 6144 + 6144 + 2 * 1024;
#pragma unroll 1
      for (int it = blockIdx.x; it < 8 * 32; it += gridDim.x) { const int rt = it >> 5, ct = it & 31; float o[2];
        ctx_tile(WSP(bf16_t, O_PM) + C_RV, PW, WSP(bf16_t, O_WO), 1024, 1024, rt * 32, ct * 32, o);
#pragma unroll
        for (int s = 0; s < 2; ++s) { const int e = tid + 512 * s; const int col = ct * 32 + (e & 31); X[(long)(rt * 32 + (e >> 5)) * 1024 + col] += mv[col] * o[s]; } } }
    }
    grid.sync();
    { PHASE_BEGIN
    norm_mod(WSP(float, O_X), WSP(bf16_t, O_H), p.g_ffn + l * 1024, WSP(float, O_MODS) + (size_t)l * 2 * 6144, 3, 4);
    }
    grid.sync();
    { PHASE_BEGIN
    gemm_phase<false>(WSP(bf16_t, O_H), 1024, WSP(bf16_t, O_FI), 1024, 1024, NM, 22, EpiSwiglu{WSP(bf16_t, O_ACT)});
    }
    grid.sync();
    { PHASE_BEGIN
    gemm_phase<false>(WSP(bf16_t, O_ACT), FH, WSP(bf16_t, O_FO), FH, FH, NM - 1, 4, EpiResid{WSP(float, O_X), WSP(float, O_MODS) + (size_t)l * 2 * 6144, 5}, 1);
    if (need_ctx) { const int tid = otid(); float* X = WSP(float, O_X); const float* mv = WSP(float, O_MODS) + (size_t)l * 2 * 6144 + 6144 + 5 * 1024;
#pragma unroll 1
      for (int it = blockIdx.x; it < 8 * 32; it += gridDim.x) { const int rt = it >> 5, ct = it & 31; float o[2];
        ctx_tile(WSP(bf16_t, O_ACT), FH, WSP(bf16_t, O_FO), FH, FH, rt * 32, ct * 32, o);
#pragma unroll
        for (int s = 0; s < 2; ++s) { const int e = tid + 512 * s; const int col = ct * 32 + (e & 31); X[(long)(rt * 32 + (e >> 5)) * 1024 + col] += mv[col] * o[s]; } } }
    }
    grid.sync();
  }
  { PHASE_BEGIN final_norm(WSP(float, O_X), p.g_final, p.out); }
}

extern "C" void kernel_launch(void* const* d_in, const int* in_sizes, int n_in, void* d_out, int out_size, void* d_ws, size_t ws_size, hipStream_t stream) {
  static int grid_blocks = 0;
  if (grid_blocks == 0) {
    if (n_in != 22 || ws_size < WS_END || out_size != SEQL * DM) { fprintf(stderr, "kernel_launch: unexpected shapes n_in %d ws %zu (need %zu) out %d\n", n_in, ws_size, (size_t)WS_END, out_size); grid_blocks = -1; return; }
    int dev = 0, cus = 0, per_cu = 0;
    hipGetDevice(&dev); hipDeviceGetAttribute(&cus, hipDeviceAttributeMultiprocessorCount, dev);
    if (hipFuncSetAttribute((const void*)mega, hipFuncAttributeMaxDynamicSharedMemorySize, LDS_BYTES) != hipSuccess) { fprintf(stderr, "kernel_launch: hipFuncSetAttribute failed\n"); grid_blocks = -1; return; }
    if (hipOccupancyMaxActiveBlocksPerMultiprocessor(&per_cu, (const void*)mega, 512, LDS_BYTES) != hipSuccess || per_cu < 1) { fprintf(stderr, "kernel_launch: occupancy query failed (%d)\n", per_cu); per_cu = 1; (void)hipGetLastError(); }
    grid_blocks = cus * 1;
  }
  if (grid_blocks < 0) return;
  Params p{};
  const float** pp = (const float**)&p;
  for (int i = 0; i < 22; ++i) pp[i] = (const float*)d_in[i];
  p.out = (float*)d_out; p.ws = (unsigned char*)d_ws;
  for (int h = 0; h < 4; ++h) { p.lg2[h] = (float)(log1p(-exp2(-5.0 - h)) / log(2.0)); p.lg2[4 + h] = (float)(log1p(-exp2(-5.5 - h)) / log(2.0)); }
  void* args[] = {&p};
  hipError_t e = hipLaunchCooperativeKernel((const void*)mega, dim3(grid_blocks), dim3(512), args, LDS_BYTES, stream);
  if (e != hipSuccess) fprintf(stderr, "cooperative launch failed: %s (grid %d)\n", hipGetErrorString(e), grid_blocks);
}
```

```cpp
#include <hip/hip_runtime.h>
#include <hip/hip_cooperative_groups.h>
#include <cmath>
#include <cstdio>
#include <cstdint>
namespace cg = cooperative_groups;

#define DI __device__ __forceinline__
typedef unsigned short bf16_t;
using bf16x8 = __attribute__((ext_vector_type(8))) short;
using s16x4  = __attribute__((ext_vector_type(4))) short;
using f32x16 = __attribute__((ext_vector_type(16))) float;
using f32x4  = __attribute__((ext_vector_type(4))) float;
using u32x4  = __attribute__((ext_vector_type(4))) unsigned;
using u32x2  = __attribute__((ext_vector_type(2))) unsigned;

constexpr int DM = 1024, SEQL = 16384, CTXN = 256, MR = SEQL + CTXN, DEPTH = 4;
constexpr int PW = 5376;
constexpr int C_RQ = 0, C_RK = 512, C_RV = 1024, C_RG = 2048, C_CQ = 3072, C_CKV = 3328, C_KR = 3584, C_GQ = 3616, C_GK = 4640, C_GV = 4896;
constexpr int NMAIN = 5152, NINROWS = 8448, GATE_ROW0 = 5376;
constexpr int FH = 2816, NCH = 130;
constexpr int LDS_BYTES = 163840;

constexpr size_t SZ_WIN = (size_t)NINROWS * 1024 * 2, SZ_QB = 768 * 256 * 2, SZ_KVB = 1536 * 256 * 2, SZ_SQ = 1024 * 1024 * 2,
                 SZ_FI = (size_t)5632 * 1024 * 2, SZ_FO = (size_t)1024 * FH * 2;
constexpr size_t O_WIN = 0, O_QB = O_WIN + SZ_WIN, O_KVB = O_QB + SZ_QB, O_RO = O_KVB + SZ_KVB, O_MO = O_RO + SZ_SQ, O_GO = O_MO + SZ_SQ,
                 O_WO = O_GO + SZ_SQ, O_FI = O_WO + SZ_SQ, O_FO = O_FI + SZ_FI, O_WEND = O_FO + SZ_FO;
constexpr size_t O_X = O_WEND, SZ_X = (size_t)MR * 1024 * 4;
constexpr size_t O_PM = O_X + SZ_X, SZ_PM = (size_t)MR * PW * 2;
constexpr size_t O_CB = O_PM + SZ_PM;
constexpr size_t SZ_H = (size_t)MR * 1024 * 2, SZ_S = (size_t)NCH * 2 * 4 * 256 * 128 * 2, SZ_MQ = (size_t)MR * 768 * 2, SZ_MKV = (size_t)MR * 1536 * 2;
constexpr size_t O_H = O_CB, O_S = O_H + SZ_H, O_MQ = O_S + SZ_S, O_MKV = O_MQ + SZ_MQ, O_CBEND = O_MKV + SZ_MKV;
constexpr size_t O_ZF = O_CB, SZ_ZF = (size_t)MR * 1024 * 4, O_GATES = O_ZF + SZ_ZF, SZ_GATES = (size_t)MR * 3072 * 2;
static_assert(O_GATES + SZ_GATES <= O_CBEND, "gates alias");
constexpr size_t O_MODS = O_CBEND, SZ_MODS = (size_t)DEPTH * 2 * 6144 * 4;
constexpr size_t O_T128 = O_MODS + SZ_MODS, SZ_T128 = 256 * 32 * 2 * 4, O_T32 = O_T128 + SZ_T128, SZ_T32 = 256 * 8 * 2 * 4, O_BAR = O_T32 + SZ_T32 + 256, WS_END = O_BAR + 16384;
constexpr size_t O_ACT = O_PM;
static_assert((size_t)MR * FH * 2 <= SZ_PM, "act alias");

struct Params {
  const float *x, *c, *ctx, *c_ctx, *w_mod, *b_mod, *g_mix, *w_in, *g_mla_q, *g_mla_kv, *w_mla_qb, *w_mla_kvb, *g_gqa_q, *g_gqa_k,
              *w_ret_o, *w_mla_o, *w_gqa_o, *w_out, *g_ffn, *w_ffn_in, *w_ffn_out, *g_final;
  float* out; unsigned char* ws;
  float lg2[8];
};

extern __shared__ __attribute__((aligned(16))) char smem[];
__device__ __forceinline__ const Params& kargs() { int z = 0; asm volatile("" : "+s"(z)); return *(const Params*)((const char*)__builtin_amdgcn_kernarg_segment_ptr() + z); }

DI float bf2f(bf16_t b) { return __uint_as_float(((unsigned)b) << 16); }
typedef __bf16 bf16v2_t __attribute__((ext_vector_type(2)));
typedef float f32v2_t __attribute__((ext_vector_type(2)));
DI unsigned cvtpk(float lo, float hi) { f32v2_t v = {lo, hi}; bf16v2_t b = __builtin_convertvector(v, bf16v2_t); return __builtin_bit_cast(unsigned, b); }
DI bf16_t f2bf(float x) { return (bf16_t)(cvtpk(x, 0.f) & 0xffffu); }
DI float shx(float v, int mask, int lane) { return __builtin_bit_cast(float, __builtin_amdgcn_ds_bpermute((lane ^ mask) << 2, __builtin_bit_cast(int, v))); }
DI float wsum(float v, int lane) { for (int o = 32; o > 0; o >>= 1) v += shx(v, o, lane); return v; }
DI int crow(int r, int hi) { return (r & 3) + 8 * (r >> 2) + 4 * hi; }
DI bf16x8 ld8(const bf16_t* p) { return *reinterpret_cast<const bf16x8*>(p); }
DI float sigm(float v) { return 1.f / (1.f + __expf(-v)); }
DI int otid() { int t = threadIdx.x; asm volatile("" : "+v"(t)); return t; }
DI unsigned char* opq(unsigned char* q) { int z = 0; asm volatile("" : "+s"(z)); return q + z; }
#define SBAR() __builtin_amdgcn_sched_barrier(0)
#define MFMA32(a, b, c) __builtin_amdgcn_mfma_f32_32x32x16_bf16((a), (b), (c), 0, 0, 0)

#define LAS __attribute__((address_space(3)))
constexpr int BK = 64, HALF = 128, HTB = HALF * BK * 2;
DI int lds_byte(int r, int c) { const int st = (r >> 4) * 2 + (c >> 5), rr = r & 15, cc = c & 31, ob = rr * 64 + cc * 2; return st * 1024 + (ob ^ (((ob >> 9) & 1) << 5)); }
DI void stage_rc(int b, int& R, int& C) { const int st = b / 1024, sb = b % 1024, swz = sb ^ (((sb >> 9) & 1) << 5); R = (st >> 1) * 16 + swz / 64; C = (st & 1) * 32 + (swz % 64) / 2; }
typedef f32x4 acc_t[2][2][4][2];
DI int perm32(int rho) { const int n = rho >> 4, i = rho & 15; return 8 * (i >> 2) + 4 * n + (i & 3); }

DI bool tile_map(int idx, int nM, int nN, int& pm, int& pn) {
  const int nwg = nM * nN; if (idx >= nwg) return false;
  int wgid = idx; { const int q = nwg / 8, r = nwg % 8, xcd = wgid % 8, off = wgid / 8; wgid = (xcd < r ? xcd * (q + 1) : r * (q + 1) + (xcd - r) * q) + off; }
  const int nig = 8 * nN, gid = wgid / nig, fm = gid * 8, gsz = (nM - fm) < 8 ? (nM - fm) : 8;
  pm = fm + ((wgid % nig) % gsz); pn = (wgid % nig) / gsz; return true;
}
struct Unit { int pm, pn, b; };
template <bool MERGE>
DI bool unit_next(int nM, int nN, int pm0, int ui, Unit& u) {
  const int ti = MERGE ? ui / 3 : ui; u.b = MERGE ? ui - ti * 3 : 0;
  const bool ok = tile_map(ti * (int)gridDim.x + (int)blockIdx.x, nM, nN, u.pm, u.pn); u.pm += pm0; return ok;
}
template <bool MERGE>
DI const char* unit_A(const bf16_t* A, int lda, const Unit& u) { const int off = MERGE ? (u.b == 0 ? C_RG : (u.b == 1 ? C_RQ : C_GQ)) : 0; return (const char*)(A + off) + (size_t)u.pm * 512 * lda; }
template <bool MERGE>
DI const char* unit_B(const bf16_t* B, int ldb, const Unit& u) { return (const char*)(B + (MERGE ? (size_t)u.b * 1024 * 1024 : 0)) + (size_t)u.pn * 512 * ldb; }

template <bool MERGE, class Epi>
DI void gemm_phase(const bf16_t* __restrict__ gA, const int lda, const bf16_t* __restrict__ gB, const int ldb, const int K, const int nM, const int nN, const Epi& E, const int pm0 = 0) {
  LAS unsigned char* lds = (LAS unsigned char*)smem;
  const int tid = otid(), wid = __builtin_amdgcn_readfirstlane(tid >> 6), lane = tid & 63, wr = wid >> 2, wc = wid & 3, fr = lane & 15, fq = lane >> 4;
  const int nt = K / BK;
  unsigned voffA[2], voffB[2];
#pragma unroll
  for (int i = 0; i < 2; ++i) { int R, C; stage_rc(tid * 16 + i * 8192, R, C); voffA[i] = (unsigned)(R * lda + C) * 2u; voffB[i] = (unsigned)(R * ldb + C) * 2u; }
  const size_t kstep = (size_t)(BK * 2);
  const size_t hstepA = (size_t)HALF * lda * 2, hstepB = (size_t)HALF * ldb * 2;
  const unsigned ldsw = (unsigned)wid * 1024u;
  const int aoff = lds_byte(wr * 64 + fr, fq * 8), boff = lds_byte(wc * 32 + fr, fq * 8);
#define PG8_SA(b, h) (((b) * 2 + (h)) * HTB)
#define PG8_SB(b, h) ((4 + (b) * 2 + (h)) * HTB)
#define PG8_STAGE(bufoff, gbase, voff) do { _Pragma("unroll") for (int _i = 0; _i < 2; ++_i) \
    __builtin_amdgcn_global_load_lds((const unsigned*)((const char*)(gbase) + (voff)[_i]), (LAS unsigned*)(lds + (bufoff) + ldsw + _i * 8192), 16, 0, 0); } while (0)
#define PG8_LDA(dst, b, h) do { _Pragma("unroll") for (int m = 0; m < 4; ++m) _Pragma("unroll") for (int k = 0; k < 2; ++k) dst[m][k] = *(const LAS bf16x8*)(lds + PG8_SA(b, h) + aoff + m * 2048 + k * 1024); } while (0)
#define PG8_LDB(dst, b, h) do { _Pragma("unroll") for (int n = 0; n < 2; ++n) _Pragma("unroll") for (int k = 0; k < 2; ++k) dst[n][k] = *(const LAS bf16x8*)(lds + PG8_SB(b, h) + boff + n * 2048 + k * 1024); } while (0)
#define PG8_MMA(ai, bj, At, Bt) do { __builtin_amdgcn_s_setprio(1); _Pragma("unroll") for (int m = 0; m < 4; ++m) _Pragma("unroll") for (int n = 0; n < 2; ++n) _Pragma("unroll") for (int k = 0; k < 2; ++k) \
    acc[ai][bj][m][n] = __builtin_amdgcn_mfma_f32_16x16x32_bf16(Bt[n][k], At[m][k], acc[ai][bj][m][n], 0, 0, 0); __builtin_amdgcn_s_setprio(0); } while (0)
#define PG8_WAIT_V(n) asm volatile("s_waitcnt vmcnt(" #n ")" ::: "memory")
#define PG8_WAIT_L(n) asm volatile("s_waitcnt lgkmcnt(" #n ")" ::: "memory")
#define PG8_BAR __builtin_amdgcn_s_barrier()
#define PG8_SCHED __builtin_amdgcn_sched_barrier(0)
  Unit cur, nxt; int ui = 0;
  if (!unit_next<MERGE>(nM, nN, pm0, 0, cur)) return;
  f32x4 acc[2][2][4][2];
#pragma unroll
  for (int a = 0; a < 2; ++a)
#pragma unroll
    for (int b = 0; b < 2; ++b)
#pragma unroll
      for (int m = 0; m < 4; ++m)
#pragma unroll
        for (int n = 0; n < 2; ++n) acc[a][b][m][n] = (f32x4){0.f, 0.f, 0.f, 0.f};
  bf16x8 At[4][2], B0[2][2], B1[2][2];
  const char* cA = unit_A<MERGE>(gA, lda, cur); const char* cB = unit_B<MERGE>(gB, ldb, cur);
  PG8_STAGE(PG8_SB(0, 0), cB, voffB); PG8_STAGE(PG8_SA(0, 0), cA, voffA); PG8_STAGE(PG8_SB(0, 1), cB + hstepB, voffB); PG8_STAGE(PG8_SA(0, 1), cA + hstepA, voffA);
  if (wr == 1) PG8_BAR;
  PG8_WAIT_V(4); PG8_BAR;
  PG8_STAGE(PG8_SB(1, 0), cB + kstep, voffB); PG8_STAGE(PG8_SA(1, 0), cA + kstep, voffA); PG8_STAGE(PG8_SB(1, 1), cB + hstepB + kstep, voffB);
  PG8_WAIT_V(6); PG8_BAR;
  for (;;) {
    const bool has_next = unit_next<MERGE>(nM, nN, pm0, ui + 1, nxt);
    const char* nA = has_next ? unit_A<MERGE>(gA, lda, nxt) : cA; const char* nB = has_next ? unit_B<MERGE>(gB, ldb, nxt) : cB;
#pragma unroll 1
    for (int t = 0; t < nt; t += 2) {
      const bool last = (t == nt - 2);
      const char* a1 = cA + (size_t)(t + 1) * kstep;
      const char* a2 = last ? nA : cA + (size_t)(t + 2) * kstep; const char* b2 = last ? nB : cB + (size_t)(t + 2) * kstep;
      const char* a3 = a2 + kstep; const char* b3 = b2 + kstep;
      PG8_LDB(B0, 0, 0); PG8_SCHED; PG8_LDA(At, 0, 0); PG8_STAGE(PG8_SA(1, 1), a1 + hstepA, voffA);
      PG8_WAIT_L(8); PG8_BAR; PG8_WAIT_L(0); PG8_MMA(0, 0, At, B0); PG8_BAR; PG8_SCHED;
      PG8_LDB(B1, 0, 1); PG8_STAGE(PG8_SB(0, 0), b2, voffB);
      PG8_BAR; PG8_WAIT_L(0); PG8_MMA(0, 1, At, B1); PG8_BAR;
      PG8_LDA(At, 0, 1); PG8_STAGE(PG8_SA(0, 0), a2, voffA);
      PG8_BAR; PG8_WAIT_L(0); PG8_MMA(1, 0, At, B0); PG8_BAR; PG8_SCHED;
      PG8_STAGE(PG8_SB(0, 1), b2 + hstepB, voffB);
      PG8_WAIT_V(6); PG8_BAR; PG8_MMA(1, 1, At, B1); PG8_BAR;
      PG8_LDB(B0, 1, 0); PG8_SCHED; PG8_LDA(At, 1, 0); PG8_STAGE(PG8_SA(0, 1), a2 + hstepA, voffA);
      PG8_WAIT_L(8); PG8_BAR; PG8_WAIT_L(0); PG8_MMA(0, 0, At, B0); PG8_BAR; PG8_SCHED;
      PG8_LDB(B1, 1, 1); PG8_STAGE(PG8_SB(1, 0), b3, voffB);
      PG8_BAR; PG8_WAIT_L(0); PG8_MMA(0, 1, At, B1); PG8_BAR;
      PG8_LDA(At, 1, 1); PG8_STAGE(PG8_SA(1, 0), a3, voffA);
      PG8_BAR; PG8_WAIT_L(0); PG8_MMA(1, 0, At, B0); PG8_BAR; PG8_SCHED;
      PG8_STAGE(PG8_SB(1, 1), b3 + hstepB, voffB);
      PG8_WAIT_V(6); PG8_BAR; PG8_MMA(1, 1, At, B1); PG8_BAR;
    }
    E(acc, cur.pm, cur.pn, cur.b, wr, wc, fr, fq);
    if (!has_next) break;
    if (!MERGE || cur.b == 2)
#pragma unroll
    for (int a = 0; a < 2; ++a)
#pragma unroll
      for (int b = 0; b < 2; ++b)
#pragma unroll
        for (int m = 0; m < 4; ++m)
#pragma unroll
          for (int n = 0; n < 2; ++n) acc[a][b][m][n] = (f32x4){0.f, 0.f, 0.f, 0.f};
    cur = nxt; cA = nA; cB = nB; ++ui;
  }
  PG8_WAIT_V(0);
  if (wr == 0) PG8_BAR;
  PG8_BAR;
#undef PG8_SA
#undef PG8_SB
#undef PG8_STAGE
#undef PG8_LDA
#undef PG8_LDB
#undef PG8_MMA
}

struct EpiStore { bf16_t* C; long ldc; int sig;
  DI void operator()(acc_t& acc, int pm, int pn, int ub, int wr, int wc, int fr, int fq) const {
#pragma unroll
    for (int ai = 0; ai < 2; ++ai)
#pragma unroll
      for (int m = 0; m < 4; ++m) { bf16_t* rp = C + (long)(pm * 256 + ai * 128 + wr * 64 + m * 16 + fr) * ldc + pn * 256 + wc * 32 + fq * 8;
#pragma unroll
        for (int bj = 0; bj < 2; ++bj) { f32x4 v = acc[ai][bj][m][0], w = acc[ai][bj][m][1];
          if (sig) { v[0] = sigm(v[0]); v[1] = sigm(v[1]); v[2] = sigm(v[2]); v[3] = sigm(v[3]); w[0] = sigm(w[0]); w[1] = sigm(w[1]); w[2] = sigm(w[2]); w[3] = sigm(w[3]); }
          u32x4 o = {cvtpk(v[0], v[1]), cvtpk(v[2], v[3]), cvtpk(w[0], w[1]), cvtpk(w[2], w[3])}; *(u32x4*)(rp + bj * 128) = o; } } } };
struct EpiMerge { const bf16_t* gates; bf16_t* zb; long ldz;
  DI void operator()(acc_t& acc, int pm, int pn, int b, int wr, int wc, int fr, int fq) const {
#pragma unroll
    for (int ai = 0; ai < 2; ++ai)
#pragma unroll
      for (int m = 0; m < 4; ++m) { const long row = pm * 256 + ai * 128 + wr * 64 + m * 16 + fr; const int c0 = pn * 256 + wc * 32 + fq * 8;
#pragma unroll
        for (int bj = 0; bj < 2; ++bj) { const int col = c0 + bj * 128;
          const u32x4 g = *(const u32x4*)(gates + row * 3072 + b * 1024 + col);
          float gn[8];
#pragma unroll
          for (int q = 0; q < 4; ++q) { gn[2 * q] = __uint_as_float(g[q] << 16); gn[2 * q + 1] = __uint_as_float(g[q] & 0xffff0000u); }
          if (b < 2) { const u32x4 h = *(const u32x4*)(gates + row * 3072 + (b + 1) * 1024 + col);
#pragma unroll
            for (int q = 0; q < 4; ++q) { const float d0 = __uint_as_float(h[q] << 16), d1 = __uint_as_float(h[q] & 0xffff0000u);
              const int n = q >> 1, e0 = (q & 1) * 2;
              acc[ai][bj][m][n][e0] *= gn[2 * q] * __builtin_amdgcn_rcpf(fmaxf(d0, 1e-30f)); acc[ai][bj][m][n][e0 + 1] *= gn[2 * q + 1] * __builtin_amdgcn_rcpf(fmaxf(d1, 1e-30f)); } }
          else { const f32x4 v = acc[ai][bj][m][0], w = acc[ai][bj][m][1];
            u32x4 o = {cvtpk(v[0] * gn[0], v[1] * gn[1]), cvtpk(v[2] * gn[2], v[3] * gn[3]), cvtpk(w[0] * gn[4], w[1] * gn[5]), cvtpk(w[2] * gn[6], w[3] * gn[7])};
            *(u32x4*)(zb + row * ldz + col) = o; } } } } };
struct EpiResid { float* X; const float* mods; int mi;
  DI void operator()(acc_t& acc, int pm, int pn, int ub, int wr, int wc, int fr, int fq) const {
    const float* mv = mods + (pm == 0 ? 6144 : 0) + mi * 1024;
#pragma unroll
    for (int ai = 0; ai < 2; ++ai)
#pragma unroll
      for (int m = 0; m < 4; ++m) { const long row = pm * 256 + ai * 128 + wr * 64 + m * 16 + fr; const int c0 = pn * 256 + wc * 32 + fq * 8;
#pragma unroll
        for (int bj = 0; bj < 2; ++bj)
#pragma unroll
          for (int n = 0; n < 2; ++n) { const int col = c0 + bj * 128 + n * 4; float* xp = X + row * 1024 + col;
            const f32x4 g = *(const f32x4*)(mv + col); *(f32x4*)xp = *(const f32x4*)xp + g * acc[ai][bj][m][n]; } } } };
struct EpiSwiglu { bf16_t* act;
  DI void operator()(acc_t& acc, int pm, int pn, int ub, int wr, int wc, int fr, int fq) const {
#pragma unroll
    for (int ai = 0; ai < 2; ++ai)
#pragma unroll
      for (int m = 0; m < 4; ++m) { bf16_t* rp = act + (long)(pm * 256 + ai * 128 + wr * 64 + m * 16 + fr) * FH + pn * 128 + wc * 32 + fq * 8;
        unsigned o[4];
#pragma unroll
        for (int n = 0; n < 2; ++n) { const f32x4 a = acc[ai][0][m][n], b = acc[ai][1][m][n];
          o[2 * n] = cvtpk(a[0] * sigm(a[0]) * b[0], a[1] * sigm(a[1]) * b[1]); o[2 * n + 1] = cvtpk(a[2] * sigm(a[2]) * b[2], a[3] * sigm(a[3]) * b[3]); }
        u32x4 ov = {o[0], o[1], o[2], o[3]}; *(u32x4*)rp = ov; } } };

DI void ctx_tile(const bf16_t* __restrict__ A, long lda, const bf16_t* __restrict__ B, long ldb, int K, int row0, int col0, float (&out)[2]) {
  const int tid = otid(), wid = tid >> 6, lane = tid & 63, r32 = lane & 31, hi = lane >> 5;
  float* red = (float*)smem;
  const bf16_t* ap = A + (long)(row0 + r32) * lda + hi * 8; const bf16_t* bp = B + (long)(col0 + r32) * ldb + hi * 8;
  f32x16 acc = f32x16{};
  const int nks = K >> 4;
#pragma unroll 8
  for (int ks = wid; ks < nks; ks += 8) acc = MFMA32(ld8(ap + ks * 16), ld8(bp + ks * 16), acc);
  __syncthreads();
#pragma unroll
  for (int r = 0; r < 16; ++r) red[(wid * 32 + crow(r, hi)) * 32 + r32] = acc[r];
  __syncthreads();
#pragma unroll
  for (int s = 0; s < 2; ++s) { const int e = tid + 512 * s; float v = 0.f;
#pragma unroll
    for (int w = 0; w < 8; ++w) v += red[w * 1024 + e];
    out[s] = v; }
}

constexpr int QBLK = 32, KVBLK = 64;
constexpr size_t SHM_V = KVBLK * 128 * 2, SHM_K = KVBLK * 128 * 2;
#define KSWZ(row, colB) ((row) * 256 + ((colB) ^ (((row) & 7) << 4)))

template <int FX = 0>
DI void partialSM(f32x16& p0, f32x16& p1, float& m_reg, float& mn, float& alpha, const float C, const float thr) {
  if (FX) {
    alpha = 1.f; mn = 0.f;
#pragma unroll
    for (int r = 0; r < 16; ++r) p0[r] = __builtin_amdgcn_exp2f(p0[r]);
    return; }
  float pmax = p0[0];
#pragma unroll
  for (int r = 1; r < 16; ++r) pmax = fmaxf(pmax, p0[r]);
#pragma unroll
  for (int r = 0; r < 16; ++r) pmax = fmaxf(pmax, p1[r]);
  { auto rr = __builtin_amdgcn_permlane32_swap(__float_as_uint(pmax), __float_as_uint(pmax), false, false);
    pmax = fmaxf(__uint_as_float(rr[0]), __uint_as_float(rr[1])); }
  if (__builtin_expect(__all(pmax - m_reg <= thr), 1)) { mn = m_reg; alpha = 1.f; }
  else { mn = fmaxf(m_reg, pmax); alpha = __builtin_amdgcn_exp2f((m_reg - mn) * C); m_reg = mn; }
  const float mnC = -mn * C;
#pragma unroll
  for (int r = 0; r < 16; ++r) p0[r] = fmaf(p0[r], C, mnC);
#pragma unroll
  for (int r = 0; r < 16; ++r) p1[r] = fmaf(p1[r], C, mnC);
#pragma unroll
  for (int r = 0; r < 16; ++r) p0[r] = __builtin_amdgcn_exp2f(p0[r]);
}
DI void finishSM(f32x16& p0, f32x16& p1, float alpha, float& l_reg, bf16x8& pa0, bf16x8& pa1, bf16x8& pa2, bf16x8& pa3) {
#pragma unroll
  for (int r = 0; r < 16; ++r) p1[r] = __builtin_amdgcn_exp2f(p1[r]);
  float ps = 0;
#pragma unroll
  for (int r = 0; r < 16; ++r) ps += p0[r];
#pragma unroll
  for (int r = 0; r < 16; ++r) ps += p1[r];
  { auto rr = __builtin_amdgcn_permlane32_swap(__float_as_uint(ps), __float_as_uint(ps), false, false);
    ps = __uint_as_float(rr[0]) + __uint_as_float(rr[1]); }
  l_reg = l_reg * alpha + ps;
#define PK4(P, BASE, OUT) do { unsigned a0 = cvtpk(P[BASE + 0], P[BASE + 1]), a1 = cvtpk(P[BASE + 2], P[BASE + 3]);   \
    unsigned b0 = cvtpk(P[BASE + 4], P[BASE + 5]), b1 = cvtpk(P[BASE + 6], P[BASE + 7]);                              \
    auto r0 = __builtin_amdgcn_permlane32_swap(a0, b0, false, false); auto r1 = __builtin_amdgcn_permlane32_swap(a1, b1, false, false); \
    u32x4 w = {r0[0], r1[0], r0[1], r1[1]}; OUT = *reinterpret_cast<bf16x8*>(&w); } while (0)
  PK4(p0, 0, pa0); PK4(p0, 8, pa1); PK4(p1, 0, pa2); PK4(p1, 8, pa3);
#undef PK4
}
template <int NDK>
DI void qkt(f32x16& p0, f32x16& p1, const char* Ks, const bf16x8* qr, int r32, int hi, const float init = 0.f) {
#pragma unroll
  for (int r = 0; r < 16; ++r) { p0[r] = init; p1[r] = init; }
#pragma unroll
  for (int d0 = 0; d0 < NDK; ++d0) { const int cb = (d0 * 16 + hi * 8) * 2;
    bf16x8 b0 = *reinterpret_cast<const bf16x8*>(Ks + KSWZ(r32, cb));
    bf16x8 b1 = *reinterpret_cast<const bf16x8*>(Ks + KSWZ(32 + r32, cb));
    p0 = MFMA32(b0, qr[d0], p0);
    p1 = MFMA32(b1, qr[d0], p1); }
}
DI int v_st(int k, int c) { const int kk = (k & ~0xC) | ((k & 4) << 1) | ((k & 8) >> 1); return ((kk >> 3) * 4 + (c >> 5)) * 512 + ((kk & 7) * 32 + (c & 31)) * 2; }
DI int v_rd_base(int lane) { return ((lane & 3) << 3) | (((lane >> 2) & 3) << 6) | (((lane >> 4) & 1) << 5) | (((lane >> 5) & 1) << 8); }
constexpr int v_rd_off(int d0, int ks, int half) { return d0 * 512 + ks * 4096 + half * 2048; }
template <int OFF> DI s16x4 tr_read(int vb) {
  s16x4 r; asm volatile("ds_read_b64_tr_b16 %0, %1 offset:%2" : "=&v"(r) : "v"(vb), "i"(OFF) : "memory"); return r;
}
template <int D0> DI void pv_issue(int vb, s16x4 (&r)[8]) {
  r[0] = tr_read<v_rd_off(D0, 0, 0)>(vb); r[1] = tr_read<v_rd_off(D0, 0, 1)>(vb); r[2] = tr_read<v_rd_off(D0, 1, 0)>(vb); r[3] = tr_read<v_rd_off(D0, 1, 1)>(vb);
  r[4] = tr_read<v_rd_off(D0, 2, 0)>(vb); r[5] = tr_read<v_rd_off(D0, 2, 1)>(vb); r[6] = tr_read<v_rd_off(D0, 3, 0)>(vb); r[7] = tr_read<v_rd_off(D0, 3, 1)>(vb);
}
DI void pv_mma(f32x16& od, const s16x4 (&r)[8], bf16x8 pa0, bf16x8 pa1, bf16x8 pa2, bf16x8 pa3) {
#define PK(L, H) (bf16x8){L[0], L[1], L[2], L[3], H[0], H[1], H[2], H[3]}
  od = MFMA32(pa0, PK(r[0], r[1]), od);
  od = MFMA32(pa1, PK(r[2], r[3]), od);
  od = MFMA32(pa2, PK(r[4], r[5]), od);
  od = MFMA32(pa3, PK(r[6], r[7]), od);
#undef PK
}
DI void pv_d0(f32x16* o, int vb, bf16x8 pa0, bf16x8 pa1, bf16x8 pa2, bf16x8 pa3) {
  s16x4 ra[8], rb[8];
  pv_issue<0>(vb, ra); pv_issue<1>(vb, rb);
  asm volatile("s_waitcnt lgkmcnt(8)" ::: "memory"); SBAR(); pv_mma(o[0], ra, pa0, pa1, pa2, pa3); SBAR();
  pv_issue<2>(vb, ra);
  asm volatile("s_waitcnt lgkmcnt(8)" ::: "memory"); SBAR(); pv_mma(o[1], rb, pa0, pa1, pa2, pa3); SBAR();
  pv_issue<3>(vb, rb);
  asm volatile("s_waitcnt lgkmcnt(8)" ::: "memory"); SBAR(); pv_mma(o[2], ra, pa0, pa1, pa2, pa3); SBAR();
  asm volatile("s_waitcnt lgkmcnt(0)" ::: "memory"); SBAR(); pv_mma(o[3], rb, pa0, pa1, pa2, pa3);
}

template <int NDK, int FX = 0>
DI void attn_item(const bf16_t* __restrict__ Qb, int ldq, const bf16_t* __restrict__ K0, int ldk0, const bf16_t* __restrict__ K1, int ldk1,
                  const bf16_t* __restrict__ Vh, int ldv, bf16_t* __restrict__ Ob, int ldo, int seq, const float C, const float thr, const float pinit = 0.f) {
  char* lds = smem;
  __syncthreads();
  const int tid = otid(), wid = tid >> 6, lane = tid & 63, r32 = lane & 31, hi = lane >> 5;
  char* V_lds = lds; char* K_lds = lds + 3 * SHM_V;
  float* wsb = (float*)(lds + 3 * SHM_V + 3 * SHM_K) + wid * 64; float* li_l = wsb; float* al_l = wsb + 32;
  float m_reg = -1e30f, l_reg = 0; f32x16 o[4] = {}; bf16x8 qr[NDK];
  const bf16_t* Qw = Qb + (unsigned)((wid * QBLK + r32) * ldq + hi * 8);
#pragma unroll
  for (int d0 = 0; d0 < NDK; ++d0) qr[d0] = ld8(Qw + d0 * 16);
  const int sr = tid >> 4, sc = (tid & 15) * 8, vst0 = v_st(sr, sc), vst1 = v_st(32 + sr, sc);
  const bf16_t* kp; int kld;
  if (NDK == 8 || sc < 64) { kp = K0 + sc; kld = ldk0; } else { kp = K1 + ((sc - 64) & 31); kld = ldk1; }
  const int vo0 = sr * ldv + sc, ko0 = sr * kld;
  const int vb0 = (int)(uintptr_t)V_lds + v_rd_base(lane);
  bf16x8 vs0, vs1, ks0, ks1;
#define SLOAD(k0) do { vs0 = ld8(Vh + (unsigned)((k0) * ldv + vo0)); vs1 = ld8(Vh + (unsigned)(((k0) + 32) * ldv + vo0)); \
    ks0 = ld8(kp + (unsigned)((k0) * kld + ko0)); ks1 = ld8(kp + (unsigned)(((k0) + 32) * kld + ko0)); } while (0)
#define SWRITE(b) do { *(bf16x8*)(V_lds + (b) * (int)SHM_V + vst0) = vs0; *(bf16x8*)(V_lds + (b) * (int)SHM_V + vst1) = vs1; const int kc = sc * 2; \
    *(bf16x8*)(K_lds + (b) * (int)SHM_K + KSWZ(sr, kc)) = ks0; *(bf16x8*)(K_lds + (b) * (int)SHM_K + KSWZ(32 + sr, kc)) = ks1; } while (0)
#define RESC(a) do { if (__any((a) < 1.f)) { if (hi == 0) al_l[r32] = (a); asm volatile("s_waitcnt lgkmcnt(0)" ::: "memory"); \
    for (int d = 0; d < 4; ++d) for (int r = 0; r < 16; ++r) o[d][r] *= al_l[crow(r, hi)]; } } while (0)
#define NEXTB(x) ((x) == 2 ? 0 : (x) + 1)
  f32x16 pA0, pA1, pB0, pB1; float mnA, mnB, alA, alB; bf16x8 pa0, pa1, pa2, pa3; const int NT = seq / KVBLK;
  SLOAD(0); asm volatile("s_waitcnt vmcnt(0)" ::: "memory"); SWRITE(0); SLOAD(KVBLK); __syncthreads();
  qkt<NDK>(pA0, pA1, K_lds, qr, r32, hi, pinit); partialSM<FX>(pA0, pA1, m_reg, mnA, alA, C, thr);
  asm volatile("s_waitcnt vmcnt(0)" ::: "memory"); SWRITE(1); if (2 < NT) SLOAD(2 * KVBLK);
  int bc = 1;
#define STEP(PC0, PC1, MNC, ALC, PP0, PP1, ALP, J) do { const int bp = bc == 0 ? 2 : bc - 1, bn = NEXTB(bc); \
    __syncthreads(); \
    SBAR(); qkt<NDK>(PC0, PC1, K_lds + bc * (int)SHM_K, qr, r32, hi, pinit); \
    finishSM(PP0, PP1, ALP, l_reg, pa0, pa1, pa2, pa3); SBAR(); \
    if ((J) + 1 < NT) { asm volatile("s_waitcnt vmcnt(0)" ::: "memory"); SWRITE(bn); if ((J) + 2 < NT) SLOAD(((J) + 2) * KVBLK); } SBAR(); \
    pv_d0(o, vb0 + bp * (int)SHM_V, pa0, pa1, pa2, pa3); partialSM<FX>(PC0, PC1, m_reg, MNC, ALC, C, thr); \
    if (!FX) RESC(ALC); bc = bn; } while (0)
#pragma unroll 1
  for (int j = 1; j + 1 < NT; j += 2) {
    STEP(pB0, pB1, mnB, alB, pA0, pA1, alA, j);
    STEP(pA0, pA1, mnA, alA, pB0, pB1, alB, j + 1);
  }
  STEP(pB0, pB1, mnB, alB, pA0, pA1, alA, NT - 1);
  finishSM(pB0, pB1, alB, l_reg, pa0, pa1, pa2, pa3); SBAR();
  { const int bp = bc == 0 ? 2 : bc - 1; pv_d0(o, vb0 + bp * (int)SHM_V, pa0, pa1, pa2, pa3); }
  if (hi == 0) li_l[r32] = l_reg; asm volatile("s_waitcnt lgkmcnt(0)" ::: "memory");
  float rli[16];
#pragma unroll
  for (int r = 0; r < 16; ++r) rli[r] = __builtin_amdgcn_rcpf(li_l[crow(r, hi)]);
#pragma unroll
  for (int r = 0; r < 16; ++r) { const unsigned oo = (unsigned)((wid * QBLK + crow(r, hi)) * ldo + r32);
#pragma unroll
    for (int d0 = 0; d0 < 4; ++d0) Ob[oo + d0 * 32] = f2bf(o[d0][r] * rli[r]); }
#undef SLOAD
#undef SWRITE
#undef RESC
#undef STEP
#undef NEXTB
}

DI void ret_u_item(int n, int h, const bf16_t* __restrict__ PM, bf16_t* __restrict__ S, float lgf, float lgb) {
  __syncthreads();
  const int tid = otid(), wid = tid >> 6, lane = tid & 63, r32 = lane & 31, hi = lane >> 5;
  bf16_t* Vs = (bf16_t*)smem; bf16_t* Kf = Vs + 128 * 256; bf16_t* Kb = Kf + 128 * 128;
  const long r0 = (long)n * 128;
  { bf16x8 vv[8], kk[4];
#pragma unroll
    for (int i = 0; i < 8; ++i) { const int id = tid + 512 * i, tok = id >> 5, c8 = id & 31; vv[i] = ld8(PM + (r0 + tok) * PW + C_RV + h * 256 + c8 * 8); }
#pragma unroll
    for (int i = 0; i < 4; ++i) { const int id = tid + 512 * i, tok = id >> 4, c8 = id & 15; kk[i] = ld8(PM + (r0 + tok) * PW + C_RK + h * 128 + c8 * 8); }
    SBAR();
#pragma unroll
    for (int i = 0; i < 8; ++i) { const int id = tid + 512 * i, tok = id >> 5, c8 = id & 31; *(bf16x8*)(Vs + tok * 256 + c8 * 8) = vv[i]; }
#pragma unroll
  for (int i = 0; i < 4; ++i) { const int id = tid + 512 * i, tok = id >> 4, c8 = id & 15;
    const bf16x8 kv = kk[i];
    const float zf = __builtin_amdgcn_exp2f(lgf * (float)(127 - tok)), zb = __builtin_amdgcn_exp2f(lgb * (float)tok);
    u32x4 of, ob;
#pragma unroll
    for (int j = 0; j < 4; ++j) { const float a = bf2f((bf16_t)kv[2 * j]), b = bf2f((bf16_t)kv[2 * j + 1]); of[j] = cvtpk(a * zf, b * zf); ob[j] = cvtpk(a * zb, b * zb); }
    *(u32x4*)(Kf + tok * 128 + c8 * 8) = of; *(u32x4*)(Kb + tok * 128 + c8 * 8) = ob; } }
  __syncthreads();
  f32x16 acc[2][4];
#pragma unroll
  for (int d = 0; d < 2; ++d)
#pragma unroll
    for (int b = 0; b < 4; ++b) acc[d][b] = f32x16{};
#pragma unroll 1
  for (int ks = 0; ks < 8; ++ks) {
    const int t0 = ks * 16 + 8 * hi;
    bf16x8 a;
#pragma unroll
    for (int j = 0; j < 8; ++j) a[j] = (short)Vs[(t0 + j) * 256 + wid * 32 + r32];
#pragma unroll
    for (int b = 0; b < 4; ++b) { bf16x8 bf_, bb_;
#pragma unroll
      for (int j = 0; j < 8; ++j) { bf_[j] = (short)Kf[(t0 + j) * 128 + b * 32 + r32]; bb_[j] = (short)Kb[(t0 + j) * 128 + b * 32 + r32]; }
      acc[0][b] = MFMA32(a, bf_, acc[0][b]); acc[1][b] = MFMA32(a, bb_, acc[1][b]); }
  }
#pragma unroll
  for (int d = 0; d < 2; ++d) { bf16_t* Sp = S + ((long)(d * NCH + n) * 4 + h) * 32768;
#pragma unroll
    for (int b = 0; b < 4; ++b)
#pragma unroll
      for (int r = 0; r < 16; ++r) Sp[(wid * 32 + crow(r, hi)) * 128 + b * 32 + r32] = f2bf(acc[d][b][r]); }
}

DI void ret_scan(bf16_t* __restrict__ S, const float* lg2) {
  const int npairs = 2 * 65536;
  const int tid = otid();
  for (int pi = blockIdx.x * 512 + tid; pi < npairs; pi += gridDim.x * 512) {
    const int dir = pi >> 16, e = (pi & 65535) * 2, h = e >> 15;
    const float cd = __builtin_amdgcn_exp2f(lg2[dir * 4 + h] * 128.f);
    unsigned* base = (unsigned*)(S + (long)dir * NCH * 131072 + e);
    float s0 = 0.f, s1 = 0.f;
#pragma unroll 1
    for (int st0 = 0; st0 < NCH; st0 += 10) {
      unsigned u[10];
#pragma unroll
      for (int q = 0; q < 10; ++q) { const int st = st0 + q; const int n = dir == 0 ? st : (st == 0 ? 1 : (st == 1 ? 0 : 131 - st)); u[q] = base[(long)n * 65536]; }
#pragma unroll
      for (int q = 0; q < 10; ++q) { const int st = st0 + q; const int n = dir == 0 ? st : (st == 0 ? 1 : (st == 1 ? 0 : 131 - st));
        base[(long)n * 65536] = cvtpk(s0, s1);
        s0 = cd * s0 + __uint_as_float(u[q] << 16); s1 = cd * s1 + __uint_as_float(u[q] & 0xffff0000u); }
    }
  }
}

DI void ret_out_item(int n, int h, bf16_t* __restrict__ PM, const bf16_t* __restrict__ S, float lgf, float lgb) {
  __syncthreads();
  const int tid = otid(), wid = tid >> 6, lane = tid & 63, r32 = lane & 31, hi = lane >> 5;
  char* Qs = smem; bf16_t* Vs = (bf16_t*)(smem + 32768); char* Ks = smem + 98304; bf16_t* Yb = (bf16_t*)(smem + 98304);
  const long r0 = (long)n * 128;
  { bf16x8 vv[8], qq[4], kk[4];
#pragma unroll
    for (int i = 0; i < 8; ++i) { const int id = tid + 512 * i, tok = id >> 5, c8 = id & 31; vv[i] = ld8(PM + (r0 + tok) * PW + C_RV + h * 256 + c8 * 8); }
#pragma unroll
    for (int i = 0; i < 4; ++i) { const int id = tid + 512 * i, tok = id >> 4, c8 = id & 15;
      qq[i] = ld8(PM + (r0 + tok) * PW + C_RQ + h * 128 + c8 * 8); kk[i] = ld8(PM + (r0 + tok) * PW + C_RK + h * 128 + c8 * 8); }
    SBAR();
#pragma unroll
    for (int i = 0; i < 8; ++i) { const int id = tid + 512 * i, tok = id >> 5, c8 = id & 31; *(bf16x8*)(Vs + tok * 256 + c8 * 8) = vv[i]; }
#pragma unroll
    for (int i = 0; i < 4; ++i) { const int id = tid + 512 * i, tok = id >> 4, c8 = id & 15;
      *(bf16x8*)(Qs + KSWZ(tok, c8 * 16)) = qq[i]; *(bf16x8*)(Ks + KSWZ(tok, c8 * 16)) = kk[i]; } }
  __syncthreads();
  const int qb = wid & 3, dh = wid >> 2;
  const int qi = qb * 32 + r32;
  bf16x8 pf[4][2];
#pragma unroll
  for (int kb = 0; kb < 4; ++kb) { f32x16 pt = f32x16{};
#pragma unroll 2
    for (int ks = 0; ks < 8; ++ks) { const int cb = (ks * 16 + hi * 8) * 2;
      const bf16x8 kf = *(const bf16x8*)(Ks + KSWZ(kb * 32 + r32, cb)); const bf16x8 qf = *(const bf16x8*)(Qs + KSWZ(qi, cb)); pt = MFMA32(kf, qf, pt); }
#pragma unroll
    for (int r = 0; r < 16; ++r) { const int kj = kb * 32 + crow(r, hi); const float d = (float)(qi - kj);
      float w = 0.f; if (qi >= kj) w += __builtin_amdgcn_exp2f(lgf * d); if (kj >= qi) w += __builtin_amdgcn_exp2f(-lgb * d);
      pt[r] *= w; }
#pragma unroll
    for (int s = 0; s < 2; ++s) { u32x4 w = {cvtpk(pt[8 * s], pt[8 * s + 1]), cvtpk(pt[8 * s + 2], pt[8 * s + 3]), cvtpk(pt[8 * s + 4], pt[8 * s + 5]), cvtpk(pt[8 * s + 6], pt[8 * s + 7])};
      pf[kb][s] = *reinterpret_cast<bf16x8*>(&w); } }
  __syncthreads();
  const float xf = __builtin_amdgcn_exp2f(lgf * (float)(qi + 1)), xb = __builtin_amdgcn_exp2f(lgb * (float)(128 - qi));
  const bf16_t* Sf = S + ((long)(0 * NCH + n) * 4 + h) * 32768; const bf16_t* Sb = S + ((long)(1 * NCH + n) * 4 + h) * 32768;
#pragma unroll 1
  for (int d = 0; d < 4; ++d) { const int dvb = (dh * 4 + d) * 32; const int dv = dvb + r32;
    f32x16 a1 = f32x16{}, a2 = f32x16{};
#pragma unroll 2
    for (int ks = 0; ks < 8; ++ks) { const bf16x8 qf = *(const bf16x8*)(Qs + KSWZ(qi, (ks * 16 + hi * 8) * 2));
      a1 = MFMA32(ld8(Sf + dv * 128 + ks * 16 + hi * 8), qf, a1); a2 = MFMA32(ld8(Sb + dv * 128 + ks * 16 + hi * 8), qf, a2); }
#pragma unroll
    for (int r = 0; r < 16; ++r) a1[r] = a1[r] * xf + a2[r] * xb;
#pragma unroll
    for (int kb = 0; kb < 4; ++kb)
#pragma unroll
      for (int s = 0; s < 2; ++s) { bf16x8 a; const bf16_t* vb = Vs + (kb * 32 + 16 * s + 4 * hi) * 256 + dv;
#pragma unroll
        for (int j = 0; j < 8; ++j) a[j] = (short)vb[((j & 3) + 8 * (j >> 2)) * 256];
        a1 = MFMA32(a, pf[kb][s], a1); }
#pragma unroll
    for (int r = 0; r < 16; ++r) Yb[qi * 256 + ((dvb + crow(r, hi)) ^ r32)] = f2bf(a1[r]); }
  __syncthreads();
  { const int i = tid >> 2, qd = tid & 3; const bf16_t* yr = Yb + i * 256; const int sw = i & 31;
    float ss = 0.f;
#pragma unroll 8
    for (int c = 0; c < 64; ++c) { const float v = bf2f(yr[(qd * 64 + c) ^ sw]); ss += v * v; }
    ss += shx(ss, 1, lane); ss += shx(ss, 2, lane);
    const float rn = rsqrtf(ss * (1.f / 256.f) + 1e-6f);
    bf16_t* gp = PM + (r0 + i) * PW + C_RG + h * 256 + qd * 64;
#pragma unroll 1
    for (int c8 = 0; c8 < 8; ++c8) { const bf16x8 g = ld8(gp + c8 * 8); float o[8];
#pragma unroll
      for (int j = 0; j < 8; ++j) { const float gv = bf2f((bf16_t)g[j]); o[j] = gv * sigm(gv) * bf2f(yr[(qd * 64 + c8 * 8 + j) ^ sw]) * rn; }
      u32x4 w = {cvtpk(o[0], o[1]), cvtpk(o[2], o[3]), cvtpk(o[4], o[5]), cvtpk(o[6], o[7])}; *(u32x4*)(gp + c8 * 8) = w; } }
}

DI void conv_w(const float* __restrict__ W, bf16_t* __restrict__ Wt, int K, int N, int mode, const float wsc = 1.f) {
  float* ldsf = (float*)smem; const int tid = otid(); const int nnt = N / 32, nt = nnt * (K / 128);
  for (int t0 = blockIdx.x * 4; t0 < nt; t0 += gridDim.x * 4) {
    __syncthreads();
    { const int n = tid & 31, kk = tid >> 5; float v[4][8];
#pragma unroll
      for (int q = 0; q < 4; ++q) { const int t = t0 + q; const int n0 = (t % nnt) * 32, k0 = (t / nnt) * 128;
#pragma unroll
        for (int i = 0; i < 8; ++i) v[q][i] = t < nt ? W[(long)(k0 + kk + 16 * i) * N + n0 + n] : 0.f; }
#pragma unroll
      for (int q = 0; q < 4; ++q)
#pragma unroll
        for (int i = 0; i < 8; ++i) ldsf[q * 4160 + n * 129 + kk + 16 * i] = v[q][i]; }
    __syncthreads();
#pragma unroll
    for (int q = 0; q < 4; ++q) { const int t = t0 + q; if (t < nt) { const int n0 = (t % nnt) * 32, k0 = (t / nnt) * 128;
      const int n = tid >> 4, k8 = (tid & 15) * 8; const float* s = ldsf + q * 4160 + n * 129 + k8; const int sn = n0 + n; int dn = sn;
      if (mode == 1) dn = sn < NMAIN ? sn : sn + (GATE_ROW0 - NMAIN);
      if (mode == 2) dn = sn < FH ? ((sn >> 7) * 256 + (sn & 127)) : ((((sn - FH) >> 7) * 256) + 128 + ((sn - FH) & 127));
      { const int c32 = dn & 31; dn = (dn & ~31) | (((c32 >> 2) & 1) << 4) | ((c32 >> 3) << 2) | (c32 & 3); }
      u32x4 o = {cvtpk(s[0] * wsc, s[1] * wsc), cvtpk(s[2] * wsc, s[3] * wsc), cvtpk(s[4] * wsc, s[5] * wsc), cvtpk(s[6] * wsc, s[7] * wsc)};
      *(u32x4*)(Wt + (long)dn * K + k0 + k8) = o; } }
  }
}
DI void conv_layer(const Params& p, int l) {
  unsigned char* ws = p.ws;
  conv_w(p.w_in + (size_t)l * 1024 * 8224, (bf16_t*)(ws + O_WIN), 1024, 8224, 1);
  { unsigned zz = 0u; asm volatile("" : "+v"(zz)); u32x4 z = {zz, zz, zz, zz}; u32x4* zp = (u32x4*)((bf16_t*)(ws + O_WIN) + (size_t)NMAIN * 1024);
    for (int i = blockIdx.x * 512 + otid(); i < (GATE_ROW0 - NMAIN) * 1024 / 8; i += gridDim.x * 512) zp[i] = z; }
  conv_w(p.w_mla_qb + (size_t)l * 256 * 768, (bf16_t*)(ws + O_QB), 256, 768, 0, 0.14724444f);
  conv_w(p.w_mla_kvb + (size_t)l * 256 * 1536, (bf16_t*)(ws + O_KVB), 256, 1536, 0);
  conv_w(p.w_ret_o + (size_t)l * 1024 * 1024, (bf16_t*)(ws + O_RO), 1024, 1024, 0);
  conv_w(p.w_mla_o + (size_t)l * 1024 * 1024, (bf16_t*)(ws + O_MO), 1024, 1024, 0);
  conv_w(p.w_gqa_o + (size_t)l * 1024 * 1024, (bf16_t*)(ws + O_GO), 1024, 1024, 0);
  conv_w(p.w_out + (size_t)l * 1024 * 1024, (bf16_t*)(ws + O_WO), 1024, 1024, 0);
  conv_w(p.w_ffn_in + (size_t)l * 1024 * 5632, (bf16_t*)(ws + O_FI), 1024, 5632, 2);
  conv_w(p.w_ffn_out + (size_t)l * FH * 1024, (bf16_t*)(ws + O_FO), FH, 1024, 0);
}

DI void norm_mod(const float* __restrict__ X, bf16_t* __restrict__ H, const float* __restrict__ g, const float* __restrict__ mods, int ishift, int iscale) {
  const int tid_ = otid(); const int wid = tid_ >> 6, lane = tid_ & 63;
  for (int row = blockIdx.x * 8 + wid; row < MR; row += gridDim.x * 8) {
    const float* xr = X + (long)row * 1024; const float* mv = mods + (row < CTXN ? 6144 : 0);
    f32x4 v[4]; float ss = 0.f;
#pragma unroll
    for (int i = 0; i < 4; ++i) { v[i] = *(const f32x4*)(xr + i * 256 + lane * 4); ss += v[i][0] * v[i][0] + v[i][1] * v[i][1] + v[i][2] * v[i][2] + v[i][3] * v[i][3]; }
    ss = wsum(ss, lane); const float rn = rsqrtf(ss * (1.f / 1024.f) + 1e-6f);
#pragma unroll
    for (int i = 0; i < 4; ++i) { const int c = i * 256 + lane * 4; const f32x4 gg = *(const f32x4*)(g + c), sh = *(const f32x4*)(mv + ishift * 1024 + c), sl = *(const f32x4*)(mv + iscale * 1024 + c);
      float o[4];
#pragma unroll
      for (int j = 0; j < 4; ++j) o[j] = v[i][j] * rn * gg[j] * (1.f + sl[j]) + sh[j];
      u32x2 w = {cvtpk(o[0], o[1]), cvtpk(o[2], o[3])}; *(u32x2*)(H + (long)row * 1024 + c) = w; }
  }
}

DI void st8(bf16_t* p, const float* o) { u32x4 w = {cvtpk(o[0], o[1]), cvtpk(o[2], o[3]), cvtpk(o[4], o[5]), cvtpk(o[6], o[7])}; *(u32x4*)p = w; }
DI void feat_pass(bf16_t* __restrict__ PM, const float* __restrict__ T128, const float* __restrict__ T32, const float* __restrict__ gq, const float* __restrict__ gkv,
                  const float* __restrict__ ggq, const float* __restrict__ ggk) {
  const int tid_ = otid(); const int wid = tid_ >> 6, lane = tid_ & 63;
  const int hd8 = lane >> 3, half = (lane >> 2) & 1, a = lane & 3;
  for (int row = blockIdx.x * 8 + wid; row < MR; row += gridDim.x * 8) {
    bf16_t* pr = PM + (long)row * PW; const bool lat = row >= CTXN; const int t = row - CTXN; const int rp = lat ? (t >> 6) : 0, cp = lat ? (t & 63) : 0;
    const int pos = half ? cp : rp;
    float cs[8], sn[8];
    { const f32x4* tp = (const f32x4*)(T128 + (pos * 32 + a * 8) * 2);
#pragma unroll
      for (int q = 0; q < 4; ++q) { const f32x4 tv = tp[q]; cs[2 * q] = lat ? tv[0] : 1.f; sn[2 * q] = lat ? tv[1] : 0.f; cs[2 * q + 1] = lat ? tv[2] : 1.f; sn[2 * q + 1] = lat ? tv[3] : 0.f; } }
    { const int c1 = hd8 * 128 + half * 64 + a * 8; const bf16x8 x1 = ld8(pr + c1), x2 = ld8(pr + c1 + 32); const float sc = hd8 >= 4 ? 0.08838834764831845f : 1.f;
      float o1[8], o2[8];
#pragma unroll
      for (int i = 0; i < 8; ++i) { const float u = bf2f((bf16_t)x1[i]), v = bf2f((bf16_t)x2[i]); o1[i] = (u * cs[i] - v * sn[i]) * sc; o2[i] = (v * cs[i] + u * sn[i]) * sc; }
      st8(pr + c1, o1); st8(pr + c1 + 32, o2); }
#pragma unroll
    for (int pass = 0; pass < 2; ++pass) { const int hh = pass ? (hd8 & 1) : hd8; const int c1 = (pass ? C_GK : C_GQ) + hh * 128 + half * 64 + a * 8; const float* gg = pass ? ggk : ggq;
      const bf16x8 x1 = ld8(pr + c1), x2 = ld8(pr + c1 + 32); float u[8], v[8]; float ss = 0.f;
#pragma unroll
      for (int i = 0; i < 8; ++i) { u[i] = bf2f((bf16_t)x1[i]); v[i] = bf2f((bf16_t)x2[i]); ss += u[i] * u[i] + v[i] * v[i]; }
      ss += shx(ss, 1, lane); ss += shx(ss, 2, lane); ss += shx(ss, 4, lane);
      const float rn = rsqrtf(ss * (1.f / 128.f) + 1e-6f);
      const f32x4 ga0 = *(const f32x4*)(gg + half * 64 + a * 8), ga1 = *(const f32x4*)(gg + half * 64 + a * 8 + 4), gb0 = *(const f32x4*)(gg + half * 64 + a * 8 + 32), gb1 = *(const f32x4*)(gg + half * 64 + a * 8 + 36);
      float o1[8], o2[8];
#pragma unroll
      for (int i = 0; i < 8; ++i) { const float y1 = u[i] * rn * (i < 4 ? ga0[i & 3] : ga1[i & 3]), y2 = v[i] * rn * (i < 4 ? gb0[i & 3] : gb1[i & 3]); o1[i] = y1 * cs[i] - y2 * sn[i]; o2[i] = y2 * cs[i] + y1 * sn[i]; }
      if (!pass) {
#pragma unroll
        for (int i = 0; i < 8; ++i) { o1[i] *= 0.12751743074602467f; o2[i] *= 0.12751743074602467f; } }
      if (!pass || lane < 16) { st8(pr + c1, o1); st8(pr + c1 + 32, o2); } }
    { const int which = lane >> 5, a32 = lane & 31; bf16_t* cp_ = pr + (which ? C_CKV : C_CQ) + a32 * 8; const float* gg = (which ? gkv : gq) + a32 * 8;
      const bf16x8 x = ld8(cp_); float u[8]; float ss = 0.f;
#pragma unroll
      for (int i = 0; i < 8; ++i) { u[i] = bf2f((bf16_t)x[i]); ss += u[i] * u[i]; }
      ss += shx(ss, 1, lane); ss += shx(ss, 2, lane); ss += shx(ss, 4, lane); ss += shx(ss, 8, lane); ss += shx(ss, 16, lane);
      const float rn = rsqrtf(ss * (1.f / 256.f) + 1e-6f); const f32x4 g0 = *(const f32x4*)gg, g1 = *(const f32x4*)(gg + 4);
      float o[8];
#pragma unroll
      for (int i = 0; i < 8; ++i) o[i] = u[i] * rn * (i < 4 ? g0[i & 3] : g1[i & 3]);
      st8(cp_, o); }
    if (lat && lane < 16) { const int pi = lane, hh = pi >> 3, jj = pi & 7, c1 = C_KR + hh * 16 + jj, c2 = c1 + 8; const int ps = hh ? cp : rp;
      const float c_ = T32[(ps * 8 + jj) * 2], s_ = T32[(ps * 8 + jj) * 2 + 1]; const float x1 = bf2f(pr[c1]), x2 = bf2f(pr[c2]);
      pr[c1] = f2bf(x1 * c_ - x2 * s_); pr[c2] = f2bf(x2 * c_ + x1 * s_); }
  }
}

DI void mla_norms(const bf16_t* __restrict__ MQ, const bf16_t* __restrict__ MKV, const bf16_t* __restrict__ PM, unsigned* __restrict__ mx) {
  const int tid_ = otid(); const int wid = tid_ >> 6, lane = tid_ & 63; const int h = lane >> 3, j8 = lane & 7;
  float qm = 0.f, km = 0.f;
  for (int row = blockIdx.x * 8 + wid; row < MR; row += gridDim.x * 8) {
    const u32x2* qp = (const u32x2*)(MQ + (long)row * 768 + lane * 12); float ss = 0.f;
#pragma unroll
    for (int i = 0; i < 3; ++i) { const u32x2 v = qp[i]; const float a = __uint_as_float(v[0] << 16), b = __uint_as_float(v[0] & 0xffff0000u), c = __uint_as_float(v[1] << 16), d = __uint_as_float(v[1] & 0xffff0000u); ss += a * a + b * b + c * c + d * d; }
    ss += shx(ss, 1, lane); ss += shx(ss, 2, lane); ss += shx(ss, 4, lane);
    qm = fmaxf(qm, ss);
    const bf16x8 kv = ld8(MKV + (long)row * 1536 + h * 192 + j8 * 8); float sk = 0.f;
#pragma unroll
    for (int i = 0; i < 8; ++i) { const float a = bf2f((bf16_t)kv[i]); sk += a * a; }
    sk += shx(sk, 1, lane); sk += shx(sk, 2, lane); sk += shx(sk, 4, lane);
    float sr = bf2f(PM[(long)row * PW + C_KR + (lane & 31)]); sr *= sr;
    sr += shx(sr, 1, lane); sr += shx(sr, 2, lane); sr += shx(sr, 4, lane); sr += shx(sr, 8, lane); sr += shx(sr, 16, lane);
    km = fmaxf(km, sk + sr);
  }
  if (j8 == 0) { atomicMax(mx + h, __float_as_uint(qm)); atomicMax(mx + 8 + h, __float_as_uint(km)); }
}

DI void mq_rope(bf16_t* __restrict__ MQ, const float* __restrict__ T32) {
  const int tid_ = otid(); const int wid = tid_ >> 6, lane = tid_ & 63;
  for (int row = CTXN + blockIdx.x * 8 + wid; row < MR; row += gridDim.x * 8) {
    const int t = row - CTXN, rp = t >> 6, cp = t & 63; bf16_t* pr = MQ + (long)row * 768;
#pragma unroll
    for (int i = 0; i < 2; ++i) { const int pp = lane + 64 * i, h = pp >> 4, pi = pp & 15, hh = pi >> 3, jj = pi & 7; const int c1 = h * 96 + 64 + hh * 16 + jj, c2 = c1 + 8; const int ps = hh ? cp : rp;
      const float c_ = T32[(ps * 8 + jj) * 2], s_ = T32[(ps * 8 + jj) * 2 + 1]; const float x1 = bf2f(pr[c1]), x2 = bf2f(pr[c2]);
      pr[c1] = f2bf(x1 * c_ - x2 * s_); pr[c2] = f2bf(x2 * c_ + x1 * s_); }
  }
}

DI void phase0(const Params& p) {
  unsigned char* ws = p.ws; const int tid = otid(); const long gt = (long)blockIdx.x * 512 + tid, gn = (long)gridDim.x * 512;
  { f32x4* X4 = (f32x4*)(ws + O_X); const f32x4* c4 = (const f32x4*)p.ctx; const f32x4* x4 = (const f32x4*)p.x;
    for (long i = gt; i < (long)MR * 256; i += gn) X4[i] = i < 65536 ? c4[i] : x4[i - 65536]; }
  { float* T128 = (float*)(ws + O_T128); float* T32 = (float*)(ws + O_T32);
    for (long i = gt; i < 256 * 32 + 256 * 8; i += gn) { int pos, jj; float inv; float* dst;
      if (i < 256 * 32) { pos = (int)i >> 5; jj = (int)i & 31; inv = powf(10000.f, -(float)jj / 32.f); dst = T128 + i * 2; }
      else { const int q = (int)i - 256 * 32; pos = q >> 3; jj = q & 7; inv = powf(10000.f, -(float)jj / 8.f); dst = T32 + (long)q * 2; }
      const float ang = (float)pos * inv; const float k = rintf(ang * 0.15915494309189535f);
      float r = fmaf(-k, 6.28318548202514648f, ang); r = fmaf(-k, -1.74845553e-07f, r);
      dst[0] = cosf(r); dst[1] = sinf(r); } }
  { float* sl = (float*)smem; float* red = sl + 2048; float* mods = (float*)(ws + O_MODS);
    for (int item = blockIdx.x; item < DEPTH * 48; item += gridDim.x) { const int l = item / 48, cg0 = (item % 48) * 128;
      __syncthreads();
      for (int k = tid; k < 1024; k += 512) { const float a = p.c[k], b = p.c_ctx[k]; sl[k] = a * sigm(a); sl[1024 + k] = b * sigm(b); }
      __syncthreads();
      const int col = tid & 127, ks = tid >> 7; const float* w = p.w_mod + ((size_t)l * 1024 + ks * 256) * 6144 + cg0 + col;
      float a0 = 0.f, a1 = 0.f;
#pragma unroll 8
      for (int k = 0; k < 256; ++k) { const float wv = w[(size_t)k * 6144]; a0 = fmaf(sl[ks * 256 + k], wv, a0); a1 = fmaf(sl[1024 + ks * 256 + k], wv, a1); }
      red[(ks * 128 + col) * 2] = a0; red[(ks * 128 + col) * 2 + 1] = a1;
      __syncthreads();
      if (tid < 256) { const int cc = tid & 127, which = tid >> 7; float s = 0.f;
        for (int q = 0; q < 4; ++q) s += red[(q * 128 + cc) * 2 + which];
        mods[((size_t)l * 2 + which) * 6144 + cg0 + cc] = s + p.b_mod[(size_t)l * 6144 + cg0 + cc]; } } }
}

DI void final_norm(const float* __restrict__ X, const float* __restrict__ g, float* __restrict__ out) {
  const int tid_ = otid(); const int wid = tid_ >> 6, lane = tid_ & 63;
  for (int t = blockIdx.x * 8 + wid; t < SEQL; t += gridDim.x * 8) {
    const float* xr = X + (long)(CTXN + t) * 1024; f32x4 v[4]; float ss = 0.f;
#pragma unroll
    for (int i = 0; i < 4; ++i) { v[i] = *(const f32x4*)(xr + i * 256 + lane * 4); ss += v[i][0] * v[i][0] + v[i][1] * v[i][1] + v[i][2] * v[i][2] + v[i][3] * v[i][3]; }
    ss = wsum(ss, lane); const float rn = rsqrtf(ss * (1.f / 1024.f) + 1e-6f);
#pragma unroll
    for (int i = 0; i < 4; ++i) { const int c = i * 256 + lane * 4; const f32x4 gg = *(const f32x4*)(g + c); *(f32x4*)(out + (long)t * 1024 + c) = v[i] * rn * gg; }
  }
}


#define XB_TMO      128
#define XB_XCNT(j)  (256  + 64 * (j))
#define XB_XSUB(j)  (1280 + 64 * (j))
#define XB_XGEN(j)  (2304 + 64 * (j))
#define XB_TOP      3328
#define XB_TOPGEN   3392
#define XCD_BAR_WORDS 3456
#define XB_SPIN_CAP (1u << 20)
DI unsigned xb_ld(unsigned* p)              { return __hip_atomic_load(p, __ATOMIC_RELAXED, __HIP_MEMORY_SCOPE_AGENT); }
DI unsigned xb_add(unsigned* p, unsigned v) { return __hip_atomic_fetch_add(p, v, __ATOMIC_RELAXED, __HIP_MEMORY_SCOPE_AGENT); }
DI unsigned xb_xcc_id() { return (unsigned)__builtin_amdgcn_s_getreg((3 << 11) | 20) & 0xFu; }
#define XB_SPIN(cond, bar) do { unsigned _sp = 0; while (cond) { __builtin_amdgcn_s_sleep(1); \
    if ((++_sp & 255u) == 0u) { if (xb_ld(&(bar)[XB_TMO])) break; if (_sp > XB_SPIN_CAP) { __hip_atomic_store(&(bar)[XB_TMO], 1u, __ATOMIC_RELAXED, __HIP_MEMORY_SCOPE_AGENT); break; } } } } while (0)
DI void xcd_barrier(unsigned* bar, const unsigned x, const unsigned nloc, const unsigned nx, const unsigned k) {
  asm volatile("s_waitcnt vmcnt(0)" ::: "memory");
  __syncthreads();
  if (threadIdx.x == 0) {
    __builtin_amdgcn_s_waitcnt(0);
    const unsigned old = xb_add(&bar[XB_XSUB(x)], 1u);
    const unsigned gen = k;
    if (old + 1u == (k + 1u) * nloc) {
      __builtin_amdgcn_fence(__ATOMIC_RELEASE, "agent");
      asm volatile("s_waitcnt vmcnt(0)" ::: "memory");
      const unsigned og = xb_add(&bar[XB_TOP], 1u);
      const unsigned tg = k;
      if (og + 1u == (k + 1u) * nx) xb_add(&bar[XB_TOPGEN], 1u);
      else XB_SPIN(xb_ld(&bar[XB_TOPGEN]) == tg, bar);
      __builtin_amdgcn_fence(__ATOMIC_ACQUIRE, "agent");
      xb_add(&bar[XB_XGEN(x)], 1u);
      asm volatile("s_waitcnt vmcnt(0)" ::: "memory");
    } else {
      XB_SPIN(xb_ld(&bar[XB_XGEN(x)]) == gen, bar);
      __builtin_amdgcn_fence(__ATOMIC_ACQUIRE, "agent");
      asm volatile("s_waitcnt vmcnt(0)" ::: "memory");
    }
  }
  __syncthreads();
}

#define WSP(T, off) ((T*)(ws + (off)))
#define PHASE_BEGIN const Params& p = kargs(); unsigned char* ws = p.ws;
__global__ void __launch_bounds__(512) mega(Params p_unused) {
  cg::grid_group grid = cg::this_grid();
#ifdef PROBE_T
  unsigned tacc[16]; for (int i = 0; i < 16; ++i) tacc[i] = 0u; unsigned long long tprev = __builtin_amdgcn_s_memrealtime();
#define TICK(k) do { const unsigned long long now_ = __builtin_amdgcn_s_memrealtime(); tacc[k] += (unsigned)(now_ - tprev); tprev = now_; } while (0)
#else
#define TICK(k) do {} while (0)
#endif
  constexpr int NM = MR / 256;
  const float LOG2E = 1.4426950408889634f;
  const float mlaC = 0.10206207261596577f * LOG2E, mlaT = 8.f / 0.10206207261596577f, gqaC = 0.08838834764831845f * LOG2E, gqaT = 8.f / 0.08838834764831845f;

  { const Params& p = kargs(); if (blockIdx.x == 0) { unsigned* bar = (unsigned*)(p.ws + O_BAR); for (int i = threadIdx.x; i < XCD_BAR_WORDS; i += 512) bar[i] = 0u; } }
  { const Params& p = kargs(); phase0(p); }
  { const Params& p = kargs(); conv_layer(p, 0); }
  grid.sync(); TICK(0);
  const unsigned xb_x = __builtin_amdgcn_readfirstlane(xb_xcc_id());
  { unsigned* bar = (unsigned*)(kargs().ws + O_BAR); if (threadIdx.x == 0) (void)xb_add(&bar[XB_XCNT(xb_x)], 1u); }
  grid.sync();
  unsigned xb_pack;
  { unsigned* bar = (unsigned*)(kargs().ws + O_BAR); unsigned nloc = 1u, nx = 0u;
#pragma unroll
    for (unsigned j = 0; j < 16; ++j) { const unsigned c = xb_ld(&bar[XB_XCNT(j)]); nx += (c > 0u) ? 1u : 0u; nloc = (j == xb_x) ? c : nloc; }
    nloc = nloc > 0u ? nloc : 1u; nx = nx > 0u ? nx : 1u;
    xb_pack = __builtin_amdgcn_readfirstlane(xb_x | (nloc << 8) | (nx << 16)); }
#define GSYNC(idx) do { const unsigned pk_ = __builtin_amdgcn_readfirstlane(xb_pack); xcd_barrier((unsigned*)(kargs().ws + O_BAR), pk_ & 255u, (pk_ >> 8) & 255u, pk_ >> 16, (unsigned)(l * 13 + (idx))); } while (0)
#pragma unroll 1
  for (int l = 0; l < DEPTH; ++l) {
    const bool need_ctx = l < DEPTH - 1;
    { PHASE_BEGIN
    if (l > 0) conv_layer(kargs(), l);
    norm_mod(WSP(float, O_X), WSP(bf16_t, O_H), p.g_mix + l * 1024, WSP(float, O_MODS) + (size_t)l * 2 * 6144, 0, 1);
    }
    GSYNC(0); TICK(1);
    { PHASE_BEGIN
    gemm_phase<false>(WSP(bf16_t, O_H), 1024, WSP(bf16_t, O_WIN), 1024, 1024, NM, PW / 256, EpiStore{WSP(bf16_t, O_PM), PW, 0});
    }
    GSYNC(1); TICK(2);
    { PHASE_BEGIN
    if (blockIdx.x == 0 && threadIdx.x < 16) ((unsigned*)(ws + O_BAR))[3900 + threadIdx.x] = 0u;
    feat_pass(WSP(bf16_t, O_PM), WSP(float, O_T128), WSP(float, O_T32), p.g_mla_q + l * 256, p.g_mla_kv + l * 256, p.g_gqa_q + l * 128, p.g_gqa_k + l * 128);
    }
    GSYNC(2); TICK(3);
    { PHASE_BEGIN
    gemm_phase<false>(WSP(bf16_t, O_PM) + C_CQ, PW, WSP(bf16_t, O_QB), 256, 256, NM, 3, EpiStore{WSP(bf16_t, O_MQ), 768, 0});
    gemm_phase<false>(WSP(bf16_t, O_PM) + C_CKV, PW, WSP(bf16_t, O_KVB), 256, 256, NM, 6, EpiStore{WSP(bf16_t, O_MKV), 1536, 0});
#pragma unroll 1
    for (int it = blockIdx.x; it < NCH * 4; it += gridDim.x) ret_u_item(it >> 2, it & 3, WSP(bf16_t, O_PM), WSP(bf16_t, O_S), p.lg2[it & 3], p.lg2[4 + (it & 3)]);
    }
    GSYNC(3); TICK(4);
    { PHASE_BEGIN
    mla_norms(WSP(bf16_t, O_MQ), WSP(bf16_t, O_MKV), WSP(bf16_t, O_PM), (unsigned*)(ws + O_BAR) + 3900);
    mq_rope(WSP(bf16_t, O_MQ), WSP(float, O_T32));
    ret_scan(WSP(bf16_t, O_S), p.lg2);
    }
    GSYNC(4); TICK(5);
    { PHASE_BEGIN
    { bf16_t* PM = WSP(bf16_t, O_PM);
      float gq_bound; { const int ln = otid() & 63; const float* gq_ = p.g_gqa_q + l * 128; const float* gk_ = p.g_gqa_k + l * 128;
        float mq = fmaxf(fabsf(gq_[ln]), fabsf(gq_[ln + 64])), mk = fmaxf(fabsf(gk_[ln]), fabsf(gk_[ln + 64]));
#pragma unroll
        for (int o_ = 32; o_ > 0; o_ >>= 1) { mq = fmaxf(mq, shx(mq, o_, ln)); mk = fmaxf(mk, shx(mk, o_, ln)); }
        gq_bound = __builtin_amdgcn_readfirstlane(__float_as_uint(16.322293f * mq * mk)) ? __uint_as_float(__builtin_amdgcn_readfirstlane(__float_as_uint(16.322293f * mq * mk))) : 0.f; }
      const bool gq_fixed = gq_bound < 56.f;
      const int nlat = 512, nctx = need_ctx ? 8 : 0;
#pragma unroll 1
      for (int it = blockIdx.x; it < nlat + nctx; it += gridDim.x) { const int hd = it & 7, qb = it >> 3; const bool isc = it >= nlat;
        const long q0 = (isc ? 0 : (long)(CTXN + qb * 256) * PW) + C_GQ + hd * 128;
        if (gq_fixed) attn_item<8, 1>(PM + q0, PW, PM + C_GK + (hd >> 2) * 128, PW, PM, 0, PM + C_GV + (hd >> 2) * 128, PW, PM + q0, PW, isc ? CTXN : MR, 1.f, 11.541560327111707f, -gq_bound);
        else          attn_item<8, 0>(PM + q0, PW, PM + C_GK + (hd >> 2) * 128, PW, PM, 0, PM + C_GV + (hd >> 2) * 128, PW, PM + q0, PW, isc ? CTXN : MR, 1.f, 11.541560327111707f); }
      const int n0 = need_ctx ? 0 : 2;
#pragma unroll 1
      for (int it = (blockIdx.x + gridDim.x - 8) % gridDim.x; it < (NCH - n0) * 4; it += gridDim.x) { const int n = n0 + (it >> 2), h = it & 3; ret_out_item(    n, h, PM, WSP(bf16_t, O_S), p.lg2[h], p.lg2[4 + h]); } }
    }
    GSYNC(5); TICK(6);
    { PHASE_BEGIN
    { bf16_t* PM = WSP(bf16_t, O_PM); const bf16_t* MQ = WSP(bf16_t, O_MQ); const bf16_t* MKV = WSP(bf16_t, O_MKV);
#pragma unroll 1
      for (int it = blockIdx.x; it < 512 + (need_ctx ? 8 : 0); it += gridDim.x) {
        const int hd = it & 7; const bool isc = it >= 512; const int qb = it >> 3; const long rq = isc ? 0 : (long)(CTXN + qb * 256);
        const unsigned* mx = (const unsigned*)(ws + O_BAR) + 3900;
        const float bnd = __uint_as_float(__builtin_amdgcn_readfirstlane(__float_as_uint(1.002f * sqrtf(__uint_as_float(xb_ld((unsigned*)mx + hd)) * __uint_as_float(xb_ld((unsigned*)mx + 8 + hd))))));
        if (bnd < 56.f) attn_item<6, 1>(MQ + rq * 768 + hd * 96, 768, MKV + hd * 192, 1536, PM + C_KR, PW, MKV + hd * 192 + 64, 1536, PM + rq * PW + C_RQ + hd * 128, PW, isc ? CTXN : MR, 1.f, 11.541560327111707f, -bnd);
        else            attn_item<6, 0>(MQ + rq * 768 + hd * 96, 768, MKV + hd * 192, 1536, PM + C_KR, PW, MKV + hd * 192 + 64, 1536, PM + rq * PW + C_RQ + hd * 128, PW, isc ? CTXN : MR, 1.f, 11.541560327111707f); } }
    }
    GSYNC(6); TICK(7);
    { PHASE_BEGIN
    gemm_phase<false>(WSP(bf16_t, O_H), 1024, WSP(bf16_t, O_WIN) + (size_t)GATE_ROW0 * 1024, 1024, 1024, NM - 1, 12, EpiStore{WSP(bf16_t, O_GATES), 3072, 1}, 1);
    if (need_ctx) { const int tid = otid(); bf16_t* G = WSP(bf16_t, O_GATES);
#pragma unroll 1
      for (int it = blockIdx.x; it < 8 * 96; it += gridDim.x) { const int rt = it / 96, ct = it - rt * 96; float o[2];
        ctx_tile(WSP(bf16_t, O_H), 1024, WSP(bf16_t, O_WIN) + (size_t)GATE_ROW0 * 1024, 1024, 1024, rt * 32, ct * 32, o);
#pragma unroll
        for (int s = 0; s < 2; ++s) { const int e = tid + 512 * s; G[(long)(rt * 32 + (e >> 5)) * 3072 + ct * 32 + perm32(e & 31)] = f2bf(sigm(o[s])); } } }
    }
    GSYNC(7); TICK(8);
    { PHASE_BEGIN
    gemm_phase<true>(WSP(bf16_t, O_PM), PW, WSP(bf16_t, O_RO), 1024, 1024, NM - 1, 4, EpiMerge{WSP(bf16_t, O_GATES), WSP(bf16_t, O_PM) + C_RV, PW}, 1);
    if (need_ctx) { const int tid = otid(); bf16_t* PM = WSP(bf16_t, O_PM); const bf16_t* G = WSP(bf16_t, O_GATES);
#pragma unroll 1
      for (int it = blockIdx.x; it < 8 * 32; it += gridDim.x) { const int rt = it >> 5, ct = it & 31; float z[2] = {0.f, 0.f};
#pragma unroll 1
        for (int b = 0; b < 3; ++b) { float o[2];
          ctx_tile(PM + (b == 0 ? C_RG : (b == 1 ? C_RQ : C_GQ)), PW, WSP(bf16_t, O_RO) + (size_t)b * 1024 * 1024, 1024, 1024, rt * 32, ct * 32, o);
#pragma unroll
          for (int s = 0; s < 2; ++s) { const int e = tid + 512 * s; z[s] += o[s] * bf2f(G[(long)(rt * 32 + (e >> 5)) * 3072 + b * 1024 + ct * 32 + perm32(e & 31)]); } }
#pragma unroll
        for (int s = 0; s < 2; ++s) { const int e = tid + 512 * s; PM[(long)(rt * 32 + (e >> 5)) * PW + C_RV + ct * 32 + perm32(e & 31)] = f2bf(z[s]); } } }
    }
    GSYNC(8); TICK(9);
    { PHASE_BEGIN
    gemm_phase<false>(WSP(bf16_t, O_PM) + C_RV, PW, WSP(bf16_t, O_WO), 1024, 1024, NM - 1, 4, EpiResid{WSP(float, O_X), WSP(float, O_MODS) + (size_t)l * 2 * 6144, 2}, 1);
    if (need_ctx) { const int tid = otid(); float* X = WSP(float, O_X); const float* mv = WSP(float, O_MODS) + (size_t)l * 2 * 6144 + 6144 + 2 * 1024;
#pragma unroll 1
      for (int it = blockIdx.x; it < 8 * 32; it += gridDim.x) { const int rt = it >> 5, ct = it & 31; float o[2];
        ctx_tile(WSP(bf16_t, O_PM) + C_RV, PW, WSP(bf16_t, O_WO), 1024, 1024, rt * 32, ct * 32, o);
#pragma unroll
        for (int s = 0; s < 2; ++s) { const int e = tid + 512 * s; const int col = ct * 32 + perm32(e & 31); X[(long)(rt * 32 + (e >> 5)) * 1024 + col] += mv[col] * o[s]; } } }
    }
    GSYNC(9); TICK(10);
    { PHASE_BEGIN
    norm_mod(WSP(float, O_X), WSP(bf16_t, O_H), p.g_ffn + l * 1024, WSP(float, O_MODS) + (size_t)l * 2 * 6144, 3, 4);
    }
    GSYNC(10); TICK(11);
    { PHASE_BEGIN
    gemm_phase<false>(WSP(bf16_t, O_H), 1024, WSP(bf16_t, O_FI), 1024, 1024, NM, 22, EpiSwiglu{WSP(bf16_t, O_ACT)});
    }
    GSYNC(11); TICK(12);
    { PHASE_BEGIN
    gemm_phase<false>(WSP(bf16_t, O_ACT), FH, WSP(bf16_t, O_FO), FH, FH, NM - 1, 4, EpiResid{WSP(float, O_X), WSP(float, O_MODS) + (size_t)l * 2 * 6144, 5}, 1);
    if (need_ctx) { const int tid = otid(); float* X = WSP(float, O_X); const float* mv = WSP(float, O_MODS) + (size_t)l * 2 * 6144 + 6144 + 5 * 1024;
#pragma unroll 1
      for (int it = blockIdx.x; it < 8 * 32; it += gridDim.x) { const int rt = it >> 5, ct = it & 31; float o[2];
        ctx_tile(WSP(bf16_t, O_ACT), FH, WSP(bf16_t, O_FO), FH, FH, rt * 32, ct * 32, o);
#pragma unroll
        for (int s = 0; s < 2; ++s) { const int e = tid + 512 * s; const int col = ct * 32 + perm32(e & 31); X[(long)(rt * 32 + (e >> 5)) * 1024 + col] += mv[col] * o[s]; } } }
    }
    GSYNC(12); TICK(13);
  }
  { PHASE_BEGIN final_norm(WSP(float, O_X), p.g_final, p.out); }
#ifdef PROBE_T
  if (blockIdx.x == 0) { const int ia[] = {PROBE_A}; unsigned a = 0; for (unsigned q = 0; q < sizeof(ia) / 4; ++q) a += tacc[ia[q]];
    const unsigned long long t0 = __builtin_amdgcn_s_memrealtime(); while (__builtin_amdgcn_s_memrealtime() - t0 < 4ull * a) __builtin_amdgcn_s_sleep(8); }
#endif
}

extern "C" void kernel_launch(void* const* d_in, const int* in_sizes, int n_in, void* d_out, int out_size, void* d_ws, size_t ws_size, hipStream_t stream) {
  static int grid_blocks = 0;
  if (grid_blocks == 0) {
    if (n_in != 22 || ws_size < WS_END || out_size != SEQL * DM) { fprintf(stderr, "kernel_launch: unexpected shapes n_in %d ws %zu (need %zu) out %d\n", n_in, ws_size, (size_t)WS_END, out_size); grid_blocks = -1; return; }
    int dev = 0, cus = 0, per_cu = 0;
    hipGetDevice(&dev); hipDeviceGetAttribute(&cus, hipDeviceAttributeMultiprocessorCount, dev);
    if (hipFuncSetAttribute((const void*)mega, hipFuncAttributeMaxDynamicSharedMemorySize, LDS_BYTES) != hipSuccess) { fprintf(stderr, "kernel_launch: hipFuncSetAttribute failed\n"); grid_blocks = -1; return; }
    if (hipOccupancyMaxActiveBlocksPerMultiprocessor(&per_cu, (const void*)mega, 512, LDS_BYTES) != hipSuccess || per_cu < 1) { fprintf(stderr, "kernel_launch: occupancy query failed (%d)\n", per_cu); per_cu = 1; (void)hipGetLastError(); }
    grid_blocks = cus * 1;
  }
  if (grid_blocks < 0) return;
  Params p{};
  const float** pp = (const float**)&p;
  for (int i = 0; i < 22; ++i) pp[i] = (const float*)d_in[i];
  p.out = (float*)d_out; p.ws = (unsigned char*)d_ws;
  for (int h = 0; h < 4; ++h) { p.lg2[h] = (float)(log1p(-exp2(-5.0 - h)) / log(2.0)); p.lg2[4 + h] = (float)(log1p(-exp2(-5.5 - h)) / log(2.0)); }
  void* args[] = {&p};
  hipError_t e = hipLaunchCooperativeKernel((const void*)mega, dim3(grid_blocks), dim3(512), args, LDS_BYTES, stream);
  if (e != hipSuccess) fprintf(stderr, "cooperative launch failed: %s (grid %d)\n", hipGetErrorString(e), grid_blocks);
}
```

```cpp
#include <hip/hip_runtime.h>
#include <hip/hip_cooperative_groups.h>
#include <cmath>
#include <cstdio>
#include <cstdint>
namespace cg = cooperative_groups;

#define DI __device__ __forceinline__
typedef unsigned short bf16_t;
using bf16x8 = __attribute__((ext_vector_type(8))) short;
using s16x4  = __attribute__((ext_vector_type(4))) short;
using f32x16 = __attribute__((ext_vector_type(16))) float;
using f32x4  = __attribute__((ext_vector_type(4))) float;
using u32x4  = __attribute__((ext_vector_type(4))) unsigned;
using u32x2  = __attribute__((ext_vector_type(2))) unsigned;

constexpr int DM = 1024, SEQL = 16384, CTXN = 256, MR = SEQL + CTXN, DEPTH = 4;
constexpr int PW = 5376;
constexpr int C_RQ = 0, C_RK = 512, C_RV = 1024, C_RG = 2048, C_CQ = 3072, C_CKV = 3328, C_KR = 3584, C_GQ = 3616, C_GK = 4640, C_GV = 4896;
constexpr int NMAIN = 5152, NINROWS = 8448, GATE_ROW0 = 5376;
constexpr int FH = 2816, NCH = 130;
constexpr int LDS_BYTES = 163840;

constexpr size_t SZ_WIN = (size_t)NINROWS * 1024 * 2, SZ_QB = 768 * 256 * 2, SZ_KVB = 1536 * 256 * 2, SZ_SQ = 1024 * 1024 * 2,
                 SZ_FI = (size_t)5632 * 1024 * 2, SZ_FO = (size_t)1024 * FH * 2;
constexpr size_t O_WIN = 0, O_QB = O_WIN + SZ_WIN, O_KVB = O_QB + SZ_QB, O_RO = O_KVB + SZ_KVB, O_MO = O_RO + SZ_SQ, O_GO = O_MO + SZ_SQ,
                 O_WO = O_GO + SZ_SQ, O_FI = O_WO + SZ_SQ, O_FO = O_FI + SZ_FI, O_WEND = O_FO + SZ_FO;
constexpr size_t O_X = O_WEND, SZ_X = (size_t)MR * 1024 * 4;
constexpr size_t O_PM = O_X + SZ_X, SZ_PM = (size_t)MR * PW * 2;
constexpr size_t O_CB = O_PM + SZ_PM;
constexpr size_t SZ_H = (size_t)MR * 1024 * 2, SZ_S = (size_t)NCH * 2 * 4 * 256 * 128 * 2, SZ_MQ = (size_t)MR * 768 * 2, SZ_MKV = (size_t)MR * 1536 * 2;
constexpr size_t O_H = O_CB, O_S = O_H + SZ_H, O_MQ = O_S + SZ_S, O_MKV = O_MQ + SZ_MQ, O_CBEND = O_MKV + SZ_MKV;
constexpr size_t O_ZF = O_CB, SZ_ZF = (size_t)MR * 1024 * 4, O_GATES = O_ZF + SZ_ZF, SZ_GATES = (size_t)MR * 3072 * 2;
static_assert(O_GATES + SZ_GATES <= O_CBEND, "gates alias");
constexpr size_t O_MODS = O_CBEND, SZ_MODS = (size_t)DEPTH * 2 * 6144 * 4;
constexpr size_t O_T128 = O_MODS + SZ_MODS, SZ_T128 = 256 * 32 * 2 * 4, O_T32 = O_T128 + SZ_T128, SZ_T32 = 256 * 8 * 2 * 4, O_BAR = O_T32 + SZ_T32 + 256, WS_END = O_BAR + 16384;
constexpr size_t O_ACT = O_PM;
static_assert((size_t)MR * FH * 2 <= SZ_PM, "act alias");

struct Params {
  const float *x, *c, *ctx, *c_ctx, *w_mod, *b_mod, *g_mix, *w_in, *g_mla_q, *g_mla_kv, *w_mla_qb, *w_mla_kvb, *g_gqa_q, *g_gqa_k,
              *w_ret_o, *w_mla_o, *w_gqa_o, *w_out, *g_ffn, *w_ffn_in, *w_ffn_out, *g_final;
  float* out; unsigned char* ws;
  float lg2[8];
};

extern __shared__ __attribute__((aligned(16))) char smem[];
__device__ __forceinline__ const Params& kargs() { int z = 0; asm volatile("" : "+s"(z)); return *(const Params*)((const char*)__builtin_amdgcn_kernarg_segment_ptr() + z); }

DI float bf2f(bf16_t b) { return __uint_as_float(((unsigned)b) << 16); }
typedef __bf16 bf16v2_t __attribute__((ext_vector_type(2)));
typedef float f32v2_t __attribute__((ext_vector_type(2)));
DI unsigned cvtpk(float lo, float hi) { f32v2_t v = {lo, hi}; bf16v2_t b = __builtin_convertvector(v, bf16v2_t); return __builtin_bit_cast(unsigned, b); }
DI bf16_t f2bf(float x) { return (bf16_t)(cvtpk(x, 0.f) & 0xffffu); }
DI float shx(float v, int mask, int lane) { return __builtin_bit_cast(float, __builtin_amdgcn_ds_bpermute((lane ^ mask) << 2, __builtin_bit_cast(int, v))); }
DI float wsum(float v, int lane) { for (int o = 32; o > 0; o >>= 1) v += shx(v, o, lane); return v; }
DI int crow(int r, int hi) { return (r & 3) + 8 * (r >> 2) + 4 * hi; }
DI bf16x8 ld8(const bf16_t* p) { return *reinterpret_cast<const bf16x8*>(p); }
DI float sigm(float v) { return 1.f / (1.f + __expf(-v)); }
DI int otid() { int t = threadIdx.x; asm volatile("" : "+v"(t)); return t; }
DI unsigned char* opq(unsigned char* q) { int z = 0; asm volatile("" : "+s"(z)); return q + z; }
#define SBAR() __builtin_amdgcn_sched_barrier(0)
#define MFMA32(a, b, c) __builtin_amdgcn_mfma_f32_32x32x16_bf16((a), (b), (c), 0, 0, 0)

#define LAS __attribute__((address_space(3)))
constexpr int BK = 64, HALF = 128, HTB = HALF * BK * 2;
DI int lds_byte(int r, int c) { const int st = (r >> 4) * 2 + (c >> 5), rr = r & 15, cc = c & 31, ob = rr * 64 + cc * 2; return st * 1024 + (ob ^ (((ob >> 9) & 1) << 5)); }
DI void stage_rc(int b, int& R, int& C) { const int st = b / 1024, sb = b % 1024, swz = sb ^ (((sb >> 9) & 1) << 5); R = (st >> 1) * 16 + swz / 64; C = (st & 1) * 32 + (swz % 64) / 2; }
typedef f32x4 acc_t[2][2][4][2];
DI int perm32(int rho) { const int n = rho >> 4, i = rho & 15; return 8 * (i >> 2) + 4 * n + (i & 3); }

DI bool tile_map(int idx, int nM, int nN, int& pm, int& pn) {
  const int nwg = nM * nN; if (idx >= nwg) return false;
  int wgid = idx; { const int q = nwg / 8, r = nwg % 8, xcd = wgid % 8, off = wgid / 8; wgid = (xcd < r ? xcd * (q + 1) : r * (q + 1) + (xcd - r) * q) + off; }
  const int nig = 8 * nN, gid = wgid / nig, fm = gid * 8, gsz = (nM - fm) < 8 ? (nM - fm) : 8;
  pm = fm + ((wgid % nig) % gsz); pn = (wgid % nig) / gsz; return true;
}
struct Unit { int pm, pn, b; };
template <bool MERGE>
DI bool unit_next(int nM, int nN, int pm0, int ui, Unit& u) {
  const int ti = MERGE ? ui / 3 : ui; u.b = MERGE ? ui - ti * 3 : 0;
  const bool ok = tile_map(ti * (int)gridDim.x + (int)blockIdx.x, nM, nN, u.pm, u.pn); u.pm += pm0; return ok;
}
template <bool MERGE>
DI const char* unit_A(const bf16_t* A, int lda, const Unit& u) { const int off = MERGE ? (u.b == 0 ? C_RG : (u.b == 1 ? C_RQ : C_GQ)) : 0; return (const char*)(A + off) + (size_t)u.pm * 512 * lda; }
template <bool MERGE>
DI const char* unit_B(const bf16_t* B, int ldb, const Unit& u) { return (const char*)(B + (MERGE ? (size_t)u.b * 1024 * 1024 : 0)) + (size_t)u.pn * 512 * ldb; }

template <bool MERGE, class Epi>
DI void gemm_phase(const bf16_t* __restrict__ gA, const int lda, const bf16_t* __restrict__ gB, const int ldb, const int K, const int nM, const int nN, const Epi& E, const int pm0 = 0) {
  LAS unsigned char* lds = (LAS unsigned char*)smem;
  const int tid = otid(), wid = __builtin_amdgcn_readfirstlane(tid >> 6), lane = tid & 63, wr = wid >> 2, wc = wid & 3, fr = lane & 15, fq = lane >> 4;
  const int nt = K / BK;
  unsigned voffA[2], voffB[2];
#pragma unroll
  for (int i = 0; i < 2; ++i) { int R, C; stage_rc(tid * 16 + i * 8192, R, C); voffA[i] = (unsigned)(R * lda + C) * 2u; voffB[i] = (unsigned)(R * ldb + C) * 2u; }
  const size_t kstep = (size_t)(BK * 2);
  const size_t hstepA = (size_t)HALF * lda * 2, hstepB = (size_t)HALF * ldb * 2;
  const unsigned ldsw = (unsigned)wid * 1024u;
  const int aoff = lds_byte(wr * 64 + fr, fq * 8), boff = lds_byte(wc * 32 + fr, fq * 8);
#define PG8_SA(b, h) (((b) * 2 + (h)) * HTB)
#define PG8_SB(b, h) ((4 + (b) * 2 + (h)) * HTB)
#define PG8_STAGE(bufoff, gbase, voff) do { _Pragma("unroll") for (int _i = 0; _i < 2; ++_i) \
    __builtin_amdgcn_global_load_lds((const unsigned*)((const char*)(gbase) + (voff)[_i]), (LAS unsigned*)(lds + (bufoff) + ldsw + _i * 8192), 16, 0, 0); } while (0)
#define PG8_LDA(dst, b, h) do { _Pragma("unroll") for (int m = 0; m < 4; ++m) _Pragma("unroll") for (int k = 0; k < 2; ++k) dst[m][k] = *(const LAS bf16x8*)(lds + PG8_SA(b, h) + aoff + m * 2048 + k * 1024); } while (0)
#define PG8_LDB(dst, b, h) do { _Pragma("unroll") for (int n = 0; n < 2; ++n) _Pragma("unroll") for (int k = 0; k < 2; ++k) dst[n][k] = *(const LAS bf16x8*)(lds + PG8_SB(b, h) + boff + n * 2048 + k * 1024); } while (0)
#define PG8_MMA(ai, bj, At, Bt) do { __builtin_amdgcn_s_setprio(1); _Pragma("unroll") for (int m = 0; m < 4; ++m) _Pragma("unroll") for (int n = 0; n < 2; ++n) _Pragma("unroll") for (int k = 0; k < 2; ++k) \
    acc[ai][bj][m][n] = __builtin_amdgcn_mfma_f32_16x16x32_bf16(Bt[n][k], At[m][k], acc[ai][bj][m][n], 0, 0, 0); __builtin_amdgcn_s_setprio(0); } while (0)
#define PG8_WAIT_V(n) asm volatile("s_waitcnt vmcnt(" #n ")" ::: "memory")
#define PG8_WAIT_L(n) asm volatile("s_waitcnt lgkmcnt(" #n ")" ::: "memory")
#define PG8_BAR __builtin_amdgcn_s_barrier()
#define PG8_SCHED __builtin_amdgcn_sched_barrier(0)
  Unit cur, nxt; int ui = 0;
  if (!unit_next<MERGE>(nM, nN, pm0, 0, cur)) return;
  f32x4 acc[2][2][4][2];
#pragma unroll
  for (int a = 0; a < 2; ++a)
#pragma unroll
    for (int b = 0; b < 2; ++b)
#pragma unroll
      for (int m = 0; m < 4; ++m)
#pragma unroll
        for (int n = 0; n < 2; ++n) acc[a][b][m][n] = (f32x4){0.f, 0.f, 0.f, 0.f};
  bf16x8 At[4][2], B0[2][2], B1[2][2];
  const char* cA = unit_A<MERGE>(gA, lda, cur); const char* cB = unit_B<MERGE>(gB, ldb, cur);
  PG8_STAGE(PG8_SB(0, 0), cB, voffB); PG8_STAGE(PG8_SA(0, 0), cA, voffA); PG8_STAGE(PG8_SB(0, 1), cB + hstepB, voffB); PG8_STAGE(PG8_SA(0, 1), cA + hstepA, voffA);
  if (wr == 1) PG8_BAR;
  PG8_WAIT_V(4); PG8_BAR;
  PG8_STAGE(PG8_SB(1, 0), cB + kstep, voffB); PG8_STAGE(PG8_SA(1, 0), cA + kstep, voffA); PG8_STAGE(PG8_SB(1, 1), cB + hstepB + kstep, voffB);
  PG8_WAIT_V(6); PG8_BAR;
  for (;;) {
    const bool has_next = unit_next<MERGE>(nM, nN, pm0, ui + 1, nxt);
    const char* nA = has_next ? unit_A<MERGE>(gA, lda, nxt) : cA; const char* nB = has_next ? unit_B<MERGE>(gB, ldb, nxt) : cB;
#pragma unroll 1
    for (int t = 0; t < nt; t += 2) {
      const bool last = (t == nt - 2);
      const char* a1 = cA + (size_t)(t + 1) * kstep;
      const char* a2 = last ? nA : cA + (size_t)(t + 2) * kstep; const char* b2 = last ? nB : cB + (size_t)(t + 2) * kstep;
      const char* a3 = a2 + kstep; const char* b3 = b2 + kstep;
      PG8_LDB(B0, 0, 0); PG8_SCHED; PG8_LDA(At, 0, 0); PG8_STAGE(PG8_SA(1, 1), a1 + hstepA, voffA);
      PG8_WAIT_L(8); PG8_BAR; PG8_WAIT_L(0); PG8_MMA(0, 0, At, B0); PG8_BAR; PG8_SCHED;
      PG8_LDB(B1, 0, 1); PG8_STAGE(PG8_SB(0, 0), b2, voffB);
      PG8_BAR; PG8_WAIT_L(0); PG8_MMA(0, 1, At, B1); PG8_BAR;
      PG8_LDA(At, 0, 1); PG8_STAGE(PG8_SA(0, 0), a2, voffA);
      PG8_BAR; PG8_WAIT_L(0); PG8_MMA(1, 0, At, B0); PG8_BAR; PG8_SCHED;
      PG8_STAGE(PG8_SB(0, 1), b2 + hstepB, voffB);
      PG8_WAIT_V(6); PG8_BAR; PG8_MMA(1, 1, At, B1); PG8_BAR;
      PG8_LDB(B0, 1, 0); PG8_SCHED; PG8_LDA(At, 1, 0); PG8_STAGE(PG8_SA(0, 1), a2 + hstepA, voffA);
      PG8_WAIT_L(8); PG8_BAR; PG8_WAIT_L(0); PG8_MMA(0, 0, At, B0); PG8_BAR; PG8_SCHED;
      PG8_LDB(B1, 1, 1); PG8_STAGE(PG8_SB(1, 0), b3, voffB);
      PG8_BAR; PG8_WAIT_L(0); PG8_MMA(0, 1, At, B1); PG8_BAR;
      PG8_LDA(At, 1, 1); PG8_STAGE(PG8_SA(1, 0), a3, voffA);
      PG8_BAR; PG8_WAIT_L(0); PG8_MMA(1, 0, At, B0); PG8_BAR; PG8_SCHED;
      PG8_STAGE(PG8_SB(1, 1), b3 + hstepB, voffB);
      PG8_WAIT_V(6); PG8_BAR; PG8_MMA(1, 1, At, B1); PG8_BAR;
    }
    E(acc, cur.pm, cur.pn, cur.b, wr, wc, fr, fq);
    if (!has_next) break;
    if (!MERGE || cur.b == 2)
#pragma unroll
    for (int a = 0; a < 2; ++a)
#pragma unroll
      for (int b = 0; b < 2; ++b)
#pragma unroll
        for (int m = 0; m < 4; ++m)
#pragma unroll
          for (int n = 0; n < 2; ++n) acc[a][b][m][n] = (f32x4){0.f, 0.f, 0.f, 0.f};
    cur = nxt; cA = nA; cB = nB; ++ui;
  }
  PG8_WAIT_V(0);
  if (wr == 0) PG8_BAR;
  PG8_BAR;
#undef PG8_SA
#undef PG8_SB
#undef PG8_STAGE
#undef PG8_LDA
#undef PG8_LDB
#undef PG8_MMA
}

struct EpiStore { bf16_t* C; long ldc; int sig;
  DI void operator()(acc_t& acc, int pm, int pn, int ub, int wr, int wc, int fr, int fq) const {
#pragma unroll
    for (int ai = 0; ai < 2; ++ai)
#pragma unroll
      for (int m = 0; m < 4; ++m) { bf16_t* rp = C + (long)(pm * 256 + ai * 128 + wr * 64 + m * 16 + fr) * ldc + pn * 256 + wc * 32 + fq * 8;
#pragma unroll
        for (int bj = 0; bj < 2; ++bj) { f32x4 v = acc[ai][bj][m][0], w = acc[ai][bj][m][1];
          if (sig) { v[0] = sigm(v[0]); v[1] = sigm(v[1]); v[2] = sigm(v[2]); v[3] = sigm(v[3]); w[0] = sigm(w[0]); w[1] = sigm(w[1]); w[2] = sigm(w[2]); w[3] = sigm(w[3]); }
          u32x4 o = {cvtpk(v[0], v[1]), cvtpk(v[2], v[3]), cvtpk(w[0], w[1]), cvtpk(w[2], w[3])}; *(u32x4*)(rp + bj * 128) = o; } } } };
struct EpiMerge { const bf16_t* gates; bf16_t* zb; long ldz;
  DI void operator()(acc_t& acc, int pm, int pn, int b, int wr, int wc, int fr, int fq) const {
#pragma unroll
    for (int ai = 0; ai < 2; ++ai)
#pragma unroll
      for (int m = 0; m < 4; ++m) { const long row = pm * 256 + ai * 128 + wr * 64 + m * 16 + fr; const int c0 = pn * 256 + wc * 32 + fq * 8;
#pragma unroll
        for (int bj = 0; bj < 2; ++bj) { const int col = c0 + bj * 128;
          const u32x4 g = *(const u32x4*)(gates + row * 3072 + b * 1024 + col);
          float gn[8];
#pragma unroll
          for (int q = 0; q < 4; ++q) { gn[2 * q] = __uint_as_float(g[q] << 16); gn[2 * q + 1] = __uint_as_float(g[q] & 0xffff0000u); }
          if (b < 2) { const u32x4 h = *(const u32x4*)(gates + row * 3072 + (b + 1) * 1024 + col);
#pragma unroll
            for (int q = 0; q < 4; ++q) { const float d0 = __uint_as_float(h[q] << 16), d1 = __uint_as_float(h[q] & 0xffff0000u);
              const int n = q >> 1, e0 = (q & 1) * 2;
              acc[ai][bj][m][n][e0] *= gn[2 * q] * __builtin_amdgcn_rcpf(fmaxf(d0, 1e-30f)); acc[ai][bj][m][n][e0 + 1] *= gn[2 * q + 1] * __builtin_amdgcn_rcpf(fmaxf(d1, 1e-30f)); } }
          else { const f32x4 v = acc[ai][bj][m][0], w = acc[ai][bj][m][1];
            u32x4 o = {cvtpk(v[0] * gn[0], v[1] * gn[1]), cvtpk(v[2] * gn[2], v[3] * gn[3]), cvtpk(w[0] * gn[4], w[1] * gn[5]), cvtpk(w[2] * gn[6], w[3] * gn[7])};
            *(u32x4*)(zb + row * ldz + col) = o; } } } } };
struct EpiResid { float* X; const float* mods; int mi;
  DI void operator()(acc_t& acc, int pm, int pn, int ub, int wr, int wc, int fr, int fq) const {
    const float* mv = mods + (pm == 0 ? 6144 : 0) + mi * 1024;
#pragma unroll
    for (int ai = 0; ai < 2; ++ai)
#pragma unroll
      for (int m = 0; m < 4; ++m) { const long row = pm * 256 + ai * 128 + wr * 64 + m * 16 + fr; const int c0 = pn * 256 + wc * 32 + fq * 8;
#pragma unroll
        for (int bj = 0; bj < 2; ++bj)
#pragma unroll
          for (int n = 0; n < 2; ++n) { const int col = c0 + bj * 128 + n * 4; float* xp = X + row * 1024 + col;
            const f32x4 g = *(const f32x4*)(mv + col); *(f32x4*)xp = *(const f32x4*)xp + g * acc[ai][bj][m][n]; } } } };
struct EpiSwiglu { bf16_t* act;
  DI void operator()(acc_t& acc, int pm, int pn, int ub, int wr, int wc, int fr, int fq) const {
#pragma unroll
    for (int ai = 0; ai < 2; ++ai)
#pragma unroll
      for (int m = 0; m < 4; ++m) { bf16_t* rp = act + (long)(pm * 256 + ai * 128 + wr * 64 + m * 16 + fr) * FH + pn * 128 + wc * 32 + fq * 8;
        unsigned o[4];
#pragma unroll
        for (int n = 0; n < 2; ++n) { const f32x4 a = acc[ai][0][m][n], b = acc[ai][1][m][n];
          o[2 * n] = cvtpk(a[0] * sigm(a[0]) * b[0], a[1] * sigm(a[1]) * b[1]); o[2 * n + 1] = cvtpk(a[2] * sigm(a[2]) * b[2], a[3] * sigm(a[3]) * b[3]); }
        u32x4 ov = {o[0], o[1], o[2], o[3]}; *(u32x4*)rp = ov; } } };

DI void ctx_tile(const bf16_t* __restrict__ A, long lda, const bf16_t* __restrict__ B, long ldb, int K, int row0, int col0, float (&out)[2]) {
  const int tid = otid(), wid = tid >> 6, lane = tid & 63, r32 = lane & 31, hi = lane >> 5;
  float* red = (float*)smem;
  const bf16_t* ap = A + (long)(row0 + r32) * lda + hi * 8; const bf16_t* bp = B + (long)(col0 + r32) * ldb + hi * 8;
  f32x16 acc = f32x16{};
  const int nks = K >> 4;
#pragma unroll 4
  for (int ks = wid; ks < nks; ks += 8) acc = MFMA32(ld8(ap + ks * 16), ld8(bp + ks * 16), acc);
  __syncthreads();
#pragma unroll
  for (int r = 0; r < 16; ++r) red[(wid * 32 + crow(r, hi)) * 32 + r32] = acc[r];
  __syncthreads();
#pragma unroll
  for (int s = 0; s < 2; ++s) { const int e = tid + 512 * s; float v = 0.f;
#pragma unroll
    for (int w = 0; w < 8; ++w) v += red[w * 1024 + e];
    out[s] = v; }
}

constexpr int QBLK = 32, KVBLK = 64;
constexpr size_t SHM_V = KVBLK * 128 * 2, SHM_K = KVBLK * 128 * 2;
#define KSWZ(row, colB) ((row) * 256 + ((colB) ^ (((row) & 15) << 4)))

template <int FX = 0>
DI void partialSM(f32x16& p0, f32x16& p1, float& m_reg, float& mn, float& alpha, const float C, const float thr) {
  if (FX) {
    alpha = 1.f; mn = 0.f;
#pragma unroll
    for (int r = 0; r < 16; ++r) p0[r] = __builtin_amdgcn_exp2f(p0[r]);
    return; }
  float pmax = p0[0];
#pragma unroll
  for (int r = 1; r < 16; ++r) pmax = fmaxf(pmax, p0[r]);
#pragma unroll
  for (int r = 0; r < 16; ++r) pmax = fmaxf(pmax, p1[r]);
  { auto rr = __builtin_amdgcn_permlane32_swap(__float_as_uint(pmax), __float_as_uint(pmax), false, false);
    pmax = fmaxf(__uint_as_float(rr[0]), __uint_as_float(rr[1])); }
  if (__builtin_expect(__all(pmax - m_reg <= thr), 1)) { mn = m_reg; alpha = 1.f; }
  else { mn = fmaxf(m_reg, pmax); alpha = __builtin_amdgcn_exp2f((m_reg - mn) * C); m_reg = mn; }
  const float mnC = -mn * C;
#pragma unroll
  for (int r = 0; r < 16; ++r) p0[r] = fmaf(p0[r], C, mnC);
#pragma unroll
  for (int r = 0; r < 16; ++r) p1[r] = fmaf(p1[r], C, mnC);
#pragma unroll
  for (int r = 0; r < 16; ++r) p0[r] = __builtin_amdgcn_exp2f(p0[r]);
}
DI void finishSM(f32x16& p0, f32x16& p1, float alpha, float& l_reg, bf16x8& pa0, bf16x8& pa1, bf16x8& pa2, bf16x8& pa3) {
#pragma unroll
  for (int r = 0; r < 16; ++r) p1[r] = __builtin_amdgcn_exp2f(p1[r]);
  float ps = 0;
#pragma unroll
  for (int r = 0; r < 16; ++r) ps += p0[r];
#pragma unroll
  for (int r = 0; r < 16; ++r) ps += p1[r];
  { auto rr = __builtin_amdgcn_permlane32_swap(__float_as_uint(ps), __float_as_uint(ps), false, false);
    ps = __uint_as_float(rr[0]) + __uint_as_float(rr[1]); }
  l_reg = l_reg * alpha + ps;
#define PK4(P, BASE, OUT) do { unsigned a0 = cvtpk(P[BASE + 0], P[BASE + 1]), a1 = cvtpk(P[BASE + 2], P[BASE + 3]);   \
    unsigned b0 = cvtpk(P[BASE + 4], P[BASE + 5]), b1 = cvtpk(P[BASE + 6], P[BASE + 7]);                              \
    auto r0 = __builtin_amdgcn_permlane32_swap(a0, b0, false, false); auto r1 = __builtin_amdgcn_permlane32_swap(a1, b1, false, false); \
    u32x4 w = {r0[0], r1[0], r0[1], r1[1]}; OUT = *reinterpret_cast<bf16x8*>(&w); } while (0)
  PK4(p0, 0, pa0); PK4(p0, 8, pa1); PK4(p1, 0, pa2); PK4(p1, 8, pa3);
#undef PK4
}
template <int NDK>
DI void qkt(f32x16& p0, f32x16& p1, const char* Ks, const bf16x8* qr, int r32, int hi, const float init = 0.f) {
#pragma unroll
  for (int r = 0; r < 16; ++r) { p0[r] = init; p1[r] = init; }
#pragma unroll
  for (int d0 = 0; d0 < NDK; ++d0) { const int cb = (d0 * 16 + hi * 8) * 2;
    bf16x8 b0 = *reinterpret_cast<const bf16x8*>(Ks + KSWZ(r32, cb));
    bf16x8 b1 = *reinterpret_cast<const bf16x8*>(Ks + KSWZ(32 + r32, cb));
    p0 = MFMA32(b0, qr[d0], p0);
    p1 = MFMA32(b1, qr[d0], p1); }
}
DI int v_st(int k, int c) { const int kk = (k & ~0xC) | ((k & 4) << 1) | ((k & 8) >> 1); return ((kk >> 3) * 4 + (c >> 5)) * 512 + ((kk & 7) * 32 + (c & 31)) * 2; }
DI int v_rd_base(int lane) { return ((lane & 3) << 3) | (((lane >> 2) & 3) << 6) | (((lane >> 4) & 1) << 5) | (((lane >> 5) & 1) << 8); }
constexpr int v_rd_off(int d0, int ks, int half) { return d0 * 512 + ks * 4096 + half * 2048; }
template <int OFF> DI s16x4 tr_read(int vb) {
  s16x4 r; asm volatile("ds_read_b64_tr_b16 %0, %1 offset:%2" : "=&v"(r) : "v"(vb), "i"(OFF) : "memory"); return r;
}
template <int D0> DI void pv_issue(int vb, s16x4 (&r)[8]) {
  r[0] = tr_read<v_rd_off(D0, 0, 0)>(vb); r[1] = tr_read<v_rd_off(D0, 0, 1)>(vb); r[2] = tr_read<v_rd_off(D0, 1, 0)>(vb); r[3] = tr_read<v_rd_off(D0, 1, 1)>(vb);
  r[4] = tr_read<v_rd_off(D0, 2, 0)>(vb); r[5] = tr_read<v_rd_off(D0, 2, 1)>(vb); r[6] = tr_read<v_rd_off(D0, 3, 0)>(vb); r[7] = tr_read<v_rd_off(D0, 3, 1)>(vb);
}
DI void pv_mma(f32x16& od, const s16x4 (&r)[8], bf16x8 pa0, bf16x8 pa1, bf16x8 pa2, bf16x8 pa3) {
#define PK(L, H) (bf16x8){L[0], L[1], L[2], L[3], H[0], H[1], H[2], H[3]}
  od = MFMA32(pa0, PK(r[0], r[1]), od);
  od = MFMA32(pa1, PK(r[2], r[3]), od);
  od = MFMA32(pa2, PK(r[4], r[5]), od);
  od = MFMA32(pa3, PK(r[6], r[7]), od);
#undef PK
}
DI void pv_d0(f32x16* o, int vb, bf16x8 pa0, bf16x8 pa1, bf16x8 pa2, bf16x8 pa3) {
  s16x4 ra[8], rb[8];
  pv_issue<0>(vb, ra); pv_issue<1>(vb, rb);
  asm volatile("s_waitcnt lgkmcnt(8)" ::: "memory"); SBAR(); pv_mma(o[0], ra, pa0, pa1, pa2, pa3); SBAR();
  pv_issue<2>(vb, ra);
  asm volatile("s_waitcnt lgkmcnt(8)" ::: "memory"); SBAR(); pv_mma(o[1], rb, pa0, pa1, pa2, pa3); SBAR();
  pv_issue<3>(vb, rb);
  asm volatile("s_waitcnt lgkmcnt(8)" ::: "memory"); SBAR(); pv_mma(o[2], ra, pa0, pa1, pa2, pa3); SBAR();
  asm volatile("s_waitcnt lgkmcnt(0)" ::: "memory"); SBAR(); pv_mma(o[3], rb, pa0, pa1, pa2, pa3);
}

template <int NDK, int FX = 0>
DI void attn_item(const bf16_t* __restrict__ Qb, int ldq, const bf16_t* __restrict__ K0, int ldk0, const bf16_t* __restrict__ K1, int ldk1,
                  const bf16_t* __restrict__ Vh, int ldv, bf16_t* __restrict__ Ob, int ldo, int seq, const float C, const float thr, const float pinit = 0.f) {
  char* lds = smem;
  __syncthreads();
  const int tid = otid(), wid = tid >> 6, lane = tid & 63, r32 = lane & 31, hi = lane >> 5;
  char* V_lds = lds; char* K_lds = lds + 3 * SHM_V;
  float* wsb = (float*)(lds + 3 * SHM_V + 3 * SHM_K) + wid * 64; float* li_l = wsb; float* al_l = wsb + 32;
  float m_reg = -1e30f, l_reg = 0; f32x16 o[4] = {}; bf16x8 qr[NDK];
  const bf16_t* Qw = Qb + (unsigned)((wid * QBLK + r32) * ldq + hi * 8);
#pragma unroll
  for (int d0 = 0; d0 < NDK; ++d0) qr[d0] = ld8(Qw + d0 * 16);
  const int sr = tid >> 4, sc = (tid & 15) * 8, vst0 = v_st(sr, sc), vst1 = v_st(32 + sr, sc);
  const bf16_t* kp; int kld;
  if (NDK == 8 || sc < 64) { kp = K0 + sc; kld = ldk0; } else { kp = K1 + ((sc - 64) & 31); kld = ldk1; }
  const int vo0 = sr * ldv + sc, ko0 = sr * kld;
  const int vb0 = (int)(uintptr_t)V_lds + v_rd_base(lane);
  bf16x8 vs0, vs1, ks0, ks1;
#define SLOAD(k0) do { vs0 = ld8(Vh + (unsigned)((k0) * ldv + vo0)); vs1 = ld8(Vh + (unsigned)(((k0) + 32) * ldv + vo0)); \
    ks0 = ld8(kp + (unsigned)((k0) * kld + ko0)); ks1 = ld8(kp + (unsigned)(((k0) + 32) * kld + ko0)); } while (0)
#define SWRITE(b) do { *(bf16x8*)(V_lds + (b) * (int)SHM_V + vst0) = vs0; *(bf16x8*)(V_lds + (b) * (int)SHM_V + vst1) = vs1; const int kc = sc * 2; \
    *(bf16x8*)(K_lds + (b) * (int)SHM_K + KSWZ(sr, kc)) = ks0; *(bf16x8*)(K_lds + (b) * (int)SHM_K + KSWZ(32 + sr, kc)) = ks1; } while (0)
#define RESC(a) do { if (__any((a) < 1.f)) { if (hi == 0) al_l[r32] = (a); asm volatile("s_waitcnt lgkmcnt(0)" ::: "memory"); \
    for (int d = 0; d < 4; ++d) for (int r = 0; r < 16; ++r) o[d][r] *= al_l[crow(r, hi)]; } } while (0)
#define NEXTB(x) ((x) == 2 ? 0 : (x) + 1)
  f32x16 pA0, pA1, pB0, pB1; float mnA, mnB, alA, alB; bf16x8 pa0, pa1, pa2, pa3; const int NT = seq / KVBLK;
  SLOAD(0); asm volatile("s_waitcnt vmcnt(0)" ::: "memory"); SWRITE(0); SLOAD(KVBLK); __syncthreads();
  qkt<NDK>(pA0, pA1, K_lds, qr, r32, hi, pinit); partialSM<FX>(pA0, pA1, m_reg, mnA, alA, C, thr);
  asm volatile("s_waitcnt vmcnt(0)" ::: "memory"); SWRITE(1); if (2 < NT) SLOAD(2 * KVBLK);
  int bc = 1;
#define STEP(PC0, PC1, MNC, ALC, PP0, PP1, ALP, J) do { const int bp = bc == 0 ? 2 : bc - 1, bn = NEXTB(bc); \
    __syncthreads(); \
    SBAR(); qkt<NDK>(PC0, PC1, K_lds + bc * (int)SHM_K, qr, r32, hi, pinit); \
    finishSM(PP0, PP1, ALP, l_reg, pa0, pa1, pa2, pa3); SBAR(); \
    if ((J) + 1 < NT) { asm volatile("s_waitcnt vmcnt(0)" ::: "memory"); SWRITE(bn); if ((J) + 2 < NT) SLOAD(((J) + 2) * KVBLK); } SBAR(); \
    pv_d0(o, vb0 + bp * (int)SHM_V, pa0, pa1, pa2, pa3); partialSM<FX>(PC0, PC1, m_reg, MNC, ALC, C, thr); \
    if (!FX) RESC(ALC); bc = bn; } while (0)
#pragma unroll 1
  for (int j = 1; j + 1 < NT; j += 2) {
    STEP(pB0, pB1, mnB, alB, pA0, pA1, alA, j);
    STEP(pA0, pA1, mnA, alA, pB0, pB1, alB, j + 1);
  }
  STEP(pB0, pB1, mnB, alB, pA0, pA1, alA, NT - 1);
  finishSM(pB0, pB1, alB, l_reg, pa0, pa1, pa2, pa3); SBAR();
  { const int bp = bc == 0 ? 2 : bc - 1; pv_d0(o, vb0 + bp * (int)SHM_V, pa0, pa1, pa2, pa3); }
  if (hi == 0) li_l[r32] = l_reg; asm volatile("s_waitcnt lgkmcnt(0)" ::: "memory");
  float rli[16];
#pragma unroll
  for (int r = 0; r < 16; ++r) rli[r] = __builtin_amdgcn_rcpf(li_l[crow(r, hi)]);
#pragma unroll
  for (int r = 0; r < 16; ++r) { const unsigned oo = (unsigned)((wid * QBLK + crow(r, hi)) * ldo + r32);
#pragma unroll
    for (int d0 = 0; d0 < 4; ++d0) Ob[oo + d0 * 32] = f2bf(o[d0][r] * rli[r]); }
#undef SLOAD
#undef SWRITE
#undef RESC
#undef STEP
#undef NEXTB
}

DI void ret_u_item(int n, int h, const bf16_t* __restrict__ PM, bf16_t* __restrict__ S, float lgf, float lgb) {
  __syncthreads();
  const int tid = otid(), wid = tid >> 6, lane = tid & 63, r32 = lane & 31, hi = lane >> 5;
  bf16_t* Vs = (bf16_t*)smem; bf16_t* Kf = Vs + 128 * 256; bf16_t* Kb = Kf + 128 * 128;
  const long r0 = (long)n * 128;
  { bf16x8 vv[8], kk[4];
#pragma unroll
    for (int i = 0; i < 8; ++i) { const int id = tid + 512 * i, tok = id >> 5, c8 = id & 31; vv[i] = ld8(PM + (r0 + tok) * PW + C_RV + h * 256 + c8 * 8); }
#pragma unroll
    for (int i = 0; i < 4; ++i) { const int id = tid + 512 * i, tok = id >> 4, c8 = id & 15; kk[i] = ld8(PM + (r0 + tok) * PW + C_RK + h * 128 + c8 * 8); }
    SBAR();
#pragma unroll
    for (int i = 0; i < 8; ++i) { const int id = tid + 512 * i, tok = id >> 5, c8 = id & 31; *(bf16x8*)(Vs + tok * 256 + c8 * 8) = vv[i]; }
#pragma unroll
  for (int i = 0; i < 4; ++i) { const int id = tid + 512 * i, tok = id >> 4, c8 = id & 15;
    const bf16x8 kv = kk[i];
    const float zf = __builtin_amdgcn_exp2f(lgf * (float)(127 - tok)), zb = __builtin_amdgcn_exp2f(lgb * (float)tok);
    u32x4 of, ob;
#pragma unroll
    for (int j = 0; j < 4; ++j) { const float a = bf2f((bf16_t)kv[2 * j]), b = bf2f((bf16_t)kv[2 * j + 1]); of[j] = cvtpk(a * zf, b * zf); ob[j] = cvtpk(a * zb, b * zb); }
    *(u32x4*)(Kf + tok * 128 + c8 * 8) = of; *(u32x4*)(Kb + tok * 128 + c8 * 8) = ob; } }
  __syncthreads();
  f32x16 acc[2][4];
#pragma unroll
  for (int d = 0; d < 2; ++d)
#pragma unroll
    for (int b = 0; b < 4; ++b) acc[d][b] = f32x16{};
#pragma unroll 1
  for (int ks = 0; ks < 8; ++ks) {
    const int t0 = ks * 16 + 8 * hi;
    bf16x8 a;
#pragma unroll
    for (int j = 0; j < 8; ++j) a[j] = (short)Vs[(t0 + j) * 256 + wid * 32 + r32];
#pragma unroll
    for (int b = 0; b < 4; ++b) { bf16x8 bf_, bb_;
#pragma unroll
      for (int j = 0; j < 8; ++j) { bf_[j] = (short)Kf[(t0 + j) * 128 + b * 32 + r32]; bb_[j] = (short)Kb[(t0 + j) * 128 + b * 32 + r32]; }
      acc[0][b] = MFMA32(a, bf_, acc[0][b]); acc[1][b] = MFMA32(a, bb_, acc[1][b]); }
  }
#pragma unroll
  for (int d = 0; d < 2; ++d) { bf16_t* Sp = S + ((long)(d * NCH + n) * 4 + h) * 32768;
#pragma unroll
    for (int b = 0; b < 4; ++b)
#pragma unroll
      for (int r = 0; r < 16; ++r) Sp[(wid * 32 + crow(r, hi)) * 128 + b * 32 + r32] = f2bf(acc[d][b][r]); }
}

DI void ret_scan(bf16_t* __restrict__ S, const float* lg2) {
  const int npairs = 2 * 65536;
  const int tid = otid();
  for (int pi = blockIdx.x * 512 + tid; pi < npairs; pi += gridDim.x * 512) {
    const int dir = pi >> 16, e = (pi & 65535) * 2, h = e >> 15;
    const float cd = __builtin_amdgcn_exp2f(lg2[dir * 4 + h] * 128.f);
    unsigned* base = (unsigned*)(S + (long)dir * NCH * 131072 + e);
    float s0 = 0.f, s1 = 0.f;
#pragma unroll 1
    for (int st0 = 0; st0 < NCH; st0 += 10) {
      unsigned u[10];
#pragma unroll
      for (int q = 0; q < 10; ++q) { const int st = st0 + q; const int n = dir == 0 ? st : (st == 0 ? 1 : (st == 1 ? 0 : 131 - st)); u[q] = base[(long)n * 65536]; }
#pragma unroll
      for (int q = 0; q < 10; ++q) { const int st = st0 + q; const int n = dir == 0 ? st : (st == 0 ? 1 : (st == 1 ? 0 : 131 - st));
        base[(long)n * 65536] = cvtpk(s0, s1);
        s0 = cd * s0 + __uint_as_float(u[q] << 16); s1 = cd * s1 + __uint_as_float(u[q] & 0xffff0000u); }
    }
  }
}

DI void ret_out_item(int n, int h, bf16_t* __restrict__ PM, const bf16_t* __restrict__ S, float lgf, float lgb) {
  __syncthreads();
  const int tid = otid(), wid = tid >> 6, lane = tid & 63, r32 = lane & 31, hi = lane >> 5;
  char* Qs = smem; bf16_t* Vs = (bf16_t*)(smem + 32768); char* Ks = smem + 98304; bf16_t* Yb = (bf16_t*)(smem + 98304);
  const long r0 = (long)n * 128;
  { bf16x8 vv[8], qq[4], kk[4];
#pragma unroll
    for (int i = 0; i < 8; ++i) { const int id = tid + 512 * i, tok = id >> 5, c8 = id & 31; vv[i] = ld8(PM + (r0 + tok) * PW + C_RV + h * 256 + c8 * 8); }
#pragma unroll
    for (int i = 0; i < 4; ++i) { const int id = tid + 512 * i, tok = id >> 4, c8 = id & 15;
      qq[i] = ld8(PM + (r0 + tok) * PW + C_RQ + h * 128 + c8 * 8); kk[i] = ld8(PM + (r0 + tok) * PW + C_RK + h * 128 + c8 * 8); }
    SBAR();
#pragma unroll
    for (int i = 0; i < 8; ++i) { const int id = tid + 512 * i, tok = id >> 5, c8 = id & 31; *(bf16x8*)(Vs + tok * 256 + c8 * 8) = vv[i]; }
#pragma unroll
    for (int i = 0; i < 4; ++i) { const int id = tid + 512 * i, tok = id >> 4, c8 = id & 15;
      *(bf16x8*)(Qs + KSWZ(tok, c8 * 16)) = qq[i]; *(bf16x8*)(Ks + KSWZ(tok, c8 * 16)) = kk[i]; } }
  __syncthreads();
  const int qb = wid & 3, dh = wid >> 2;
  const int qi = qb * 32 + r32;
  bf16x8 pf[4][2];
#pragma unroll
  for (int kb = 0; kb < 4; ++kb) { f32x16 pt = f32x16{};
#pragma unroll 2
    for (int ks = 0; ks < 8; ++ks) { const int cb = (ks * 16 + hi * 8) * 2;
      const bf16x8 kf = *(const bf16x8*)(Ks + KSWZ(kb * 32 + r32, cb)); const bf16x8 qf = *(const bf16x8*)(Qs + KSWZ(qi, cb)); pt = MFMA32(kf, qf, pt); }
#pragma unroll
    for (int r = 0; r < 16; ++r) { const int kj = kb * 32 + crow(r, hi); const float d = (float)(qi - kj);
      float w = 0.f; if (qi >= kj) w += __builtin_amdgcn_exp2f(lgf * d); if (kj >= qi) w += __builtin_amdgcn_exp2f(-lgb * d);
      pt[r] *= w; }
#pragma unroll
    for (int s = 0; s < 2; ++s) { u32x4 w = {cvtpk(pt[8 * s], pt[8 * s + 1]), cvtpk(pt[8 * s + 2], pt[8 * s + 3]), cvtpk(pt[8 * s + 4], pt[8 * s + 5]), cvtpk(pt[8 * s + 6], pt[8 * s + 7])};
      pf[kb][s] = *reinterpret_cast<bf16x8*>(&w); } }
  __syncthreads();
  const float xf = __builtin_amdgcn_exp2f(lgf * (float)(qi + 1)), xb = __builtin_amdgcn_exp2f(lgb * (float)(128 - qi));
  const bf16_t* Sf = S + ((long)(0 * NCH + n) * 4 + h) * 32768; const bf16_t* Sb = S + ((long)(1 * NCH + n) * 4 + h) * 32768;
#pragma unroll 1
  for (int d = 0; d < 4; ++d) { const int dvb = (dh * 4 + d) * 32; const int dv = dvb + r32;
    f32x16 a1 = f32x16{}, a2 = f32x16{};
#pragma unroll 2
    for (int ks = 0; ks < 8; ++ks) { const bf16x8 qf = *(const bf16x8*)(Qs + KSWZ(qi, (ks * 16 + hi * 8) * 2));
      a1 = MFMA32(ld8(Sf + dv * 128 + ks * 16 + hi * 8), qf, a1); a2 = MFMA32(ld8(Sb + dv * 128 + ks * 16 + hi * 8), qf, a2); }
#pragma unroll
    for (int r = 0; r < 16; ++r) a1[r] = a1[r] * xf + a2[r] * xb;
#pragma unroll
    for (int kb = 0; kb < 4; ++kb)
#pragma unroll
      for (int s = 0; s < 2; ++s) { bf16x8 a; const bf16_t* vb = Vs + (kb * 32 + 16 * s + 4 * hi) * 256 + dv;
#pragma unroll
        for (int j = 0; j < 8; ++j) a[j] = (short)vb[((j & 3) + 8 * (j >> 2)) * 256];
        a1 = MFMA32(a, pf[kb][s], a1); }
#pragma unroll
    for (int r = 0; r < 16; ++r) Yb[qi * 256 + ((dvb + crow(r, hi)) ^ r32)] = f2bf(a1[r]); }
  __syncthreads();
  { const int i = tid >> 2, qd = tid & 3; const bf16_t* yr = Yb + i * 256; const int sw = i & 31;
    float ss = 0.f;
#pragma unroll 8
    for (int c = 0; c < 64; ++c) { const float v = bf2f(yr[(qd * 64 + c) ^ sw]); ss += v * v; }
    ss += shx(ss, 1, lane); ss += shx(ss, 2, lane);
    const float rn = rsqrtf(ss * (1.f / 256.f) + 1e-6f);
    bf16_t* gp = PM + (r0 + i) * PW + C_RG + h * 256 + qd * 64;
#pragma unroll 1
    for (int c8 = 0; c8 < 8; ++c8) { const bf16x8 g = ld8(gp + c8 * 8); float o[8];
#pragma unroll
      for (int j = 0; j < 8; ++j) { const float gv = bf2f((bf16_t)g[j]); o[j] = gv * sigm(gv) * bf2f(yr[(qd * 64 + c8 * 8 + j) ^ sw]) * rn; }
      u32x4 w = {cvtpk(o[0], o[1]), cvtpk(o[2], o[3]), cvtpk(o[4], o[5]), cvtpk(o[6], o[7])}; *(u32x4*)(gp + c8 * 8) = w; } }
}

DI void conv_w(const float* __restrict__ W, bf16_t* __restrict__ Wt, int K, int N, int mode, const float wsc = 1.f) {
  float* ldsf = (float*)smem; const int tid = otid(); const int nnt = N / 32, nt = nnt * (K / 128);
  for (int t0 = blockIdx.x * 4; t0 < nt; t0 += gridDim.x * 4) {
    __syncthreads();
    { const int n = tid & 31, kk = tid >> 5; float v[4][8];
#pragma unroll
      for (int q = 0; q < 4; ++q) { const int t = t0 + q; const int n0 = (t % nnt) * 32, k0 = (t / nnt) * 128;
#pragma unroll
        for (int i = 0; i < 8; ++i) v[q][i] = t < nt ? W[(long)(k0 + kk + 16 * i) * N + n0 + n] : 0.f; }
#pragma unroll
      for (int q = 0; q < 4; ++q)
#pragma unroll
        for (int i = 0; i < 8; ++i) ldsf[q * 4160 + n * 129 + kk + 16 * i] = v[q][i]; }
    __syncthreads();
#pragma unroll
    for (int q = 0; q < 4; ++q) { const int t = t0 + q; if (t < nt) { const int n0 = (t % nnt) * 32, k0 = (t / nnt) * 128;
      const int n = tid >> 4, k8 = (tid & 15) * 8; const float* s = ldsf + q * 4160 + n * 129 + k8; const int sn = n0 + n; int dn = sn;
      if (mode == 1) dn = sn < NMAIN ? sn : sn + (GATE_ROW0 - NMAIN);
      if (mode == 2) dn = sn < FH ? ((sn >> 7) * 256 + (sn & 127)) : ((((sn - FH) >> 7) * 256) + 128 + ((sn - FH) & 127));
      { const int c32 = dn & 31; dn = (dn & ~31) | (((c32 >> 2) & 1) << 4) | ((c32 >> 3) << 2) | (c32 & 3); }
      u32x4 o = {cvtpk(s[0] * wsc, s[1] * wsc), cvtpk(s[2] * wsc, s[3] * wsc), cvtpk(s[4] * wsc, s[5] * wsc), cvtpk(s[6] * wsc, s[7] * wsc)};
      *(u32x4*)(Wt + (long)dn * K + k0 + k8) = o; } }
  }
}
DI void conv_layer(const Params& p, int l) {
  unsigned char* ws = p.ws;
  conv_w(p.w_in + (size_t)l * 1024 * 8224, (bf16_t*)(ws + O_WIN), 1024, 8224, 1);
  { unsigned zz = 0u; asm volatile("" : "+v"(zz)); u32x4 z = {zz, zz, zz, zz}; u32x4* zp = (u32x4*)((bf16_t*)(ws + O_WIN) + (size_t)NMAIN * 1024);
    for (int i = blockIdx.x * 512 + otid(); i < (GATE_ROW0 - NMAIN) * 1024 / 8; i += gridDim.x * 512) zp[i] = z; }
  conv_w(p.w_mla_qb + (size_t)l * 256 * 768, (bf16_t*)(ws + O_QB), 256, 768, 0, 0.14724444f);
  conv_w(p.w_mla_kvb + (size_t)l * 256 * 1536, (bf16_t*)(ws + O_KVB), 256, 1536, 0);
  conv_w(p.w_ret_o + (size_t)l * 1024 * 1024, (bf16_t*)(ws + O_RO), 1024, 1024, 0);
  conv_w(p.w_mla_o + (size_t)l * 1024 * 1024, (bf16_t*)(ws + O_MO), 1024, 1024, 0);
  conv_w(p.w_gqa_o + (size_t)l * 1024 * 1024, (bf16_t*)(ws + O_GO), 1024, 1024, 0);
  conv_w(p.w_out + (size_t)l * 1024 * 1024, (bf16_t*)(ws + O_WO), 1024, 1024, 0);
  conv_w(p.w_ffn_in + (size_t)l * 1024 * 5632, (bf16_t*)(ws + O_FI), 1024, 5632, 2);
  conv_w(p.w_ffn_out + (size_t)l * FH * 1024, (bf16_t*)(ws + O_FO), FH, 1024, 0);
}

DI void norm_mod(const float* __restrict__ X, bf16_t* __restrict__ H, const float* __restrict__ g, const float* __restrict__ mods, int ishift, int iscale) {
  const int tid_ = otid(); const int wid = tid_ >> 6, lane = tid_ & 63;
  for (int row = blockIdx.x * 8 + wid; row < MR; row += gridDim.x * 8) {
    const float* xr = X + (long)row * 1024; const float* mv = mods + (row < CTXN ? 6144 : 0);
    f32x4 v[4]; float ss = 0.f;
#pragma unroll
    for (int i = 0; i < 4; ++i) { v[i] = *(const f32x4*)(xr + i * 256 + lane * 4); ss += v[i][0] * v[i][0] + v[i][1] * v[i][1] + v[i][2] * v[i][2] + v[i][3] * v[i][3]; }
    ss = wsum(ss, lane); const float rn = rsqrtf(ss * (1.f / 1024.f) + 1e-6f);
#pragma unroll
    for (int i = 0; i < 4; ++i) { const int c = i * 256 + lane * 4; const f32x4 gg = *(const f32x4*)(g + c), sh = *(const f32x4*)(mv + ishift * 1024 + c), sl = *(const f32x4*)(mv + iscale * 1024 + c);
      float o[4];
#pragma unroll
      for (int j = 0; j < 4; ++j) o[j] = v[i][j] * rn * gg[j] * (1.f + sl[j]) + sh[j];
      u32x2 w = {cvtpk(o[0], o[1]), cvtpk(o[2], o[3])}; *(u32x2*)(H + (long)row * 1024 + c) = w; }
  }
}

DI void st8(bf16_t* p, const float* o) { u32x4 w = {cvtpk(o[0], o[1]), cvtpk(o[2], o[3]), cvtpk(o[4], o[5]), cvtpk(o[6], o[7])}; *(u32x4*)p = w; }
DI void feat_pass(bf16_t* __restrict__ PM, const float* __restrict__ T128, const float* __restrict__ T32, const float* __restrict__ gq, const float* __restrict__ gkv,
                  const float* __restrict__ ggq, const float* __restrict__ ggk) {
  const int tid_ = otid(); const int wid = tid_ >> 6, lane = tid_ & 63;
  const int hd8 = lane >> 3, half = (lane >> 2) & 1, a = lane & 3;
  for (int row = blockIdx.x * 8 + wid; row < MR; row += gridDim.x * 8) {
    bf16_t* pr = PM + (long)row * PW; const bool lat = row >= CTXN; const int t = row - CTXN; const int rp = lat ? (t >> 6) : 0, cp = lat ? (t & 63) : 0;
    const int pos = half ? cp : rp;
    float cs[8], sn[8];
    { const f32x4* tp = (const f32x4*)(T128 + (pos * 32 + a * 8) * 2);
#pragma unroll
      for (int q = 0; q < 4; ++q) { const f32x4 tv = tp[q]; cs[2 * q] = lat ? tv[0] : 1.f; sn[2 * q] = lat ? tv[1] : 0.f; cs[2 * q + 1] = lat ? tv[2] : 1.f; sn[2 * q + 1] = lat ? tv[3] : 0.f; } }
    { const int c1 = hd8 * 128 + half * 64 + a * 8; const bf16x8 x1 = ld8(pr + c1), x2 = ld8(pr + c1 + 32); const float sc = hd8 >= 4 ? 0.08838834764831845f : 1.f;
      float o1[8], o2[8];
#pragma unroll
      for (int i = 0; i < 8; ++i) { const float u = bf2f((bf16_t)x1[i]), v = bf2f((bf16_t)x2[i]); o1[i] = (u * cs[i] - v * sn[i]) * sc; o2[i] = (v * cs[i] + u * sn[i]) * sc; }
      st8(pr + c1, o1); st8(pr + c1 + 32, o2); }
#pragma unroll
    for (int pass = 0; pass < 2; ++pass) { const int hh = pass ? (hd8 & 1) : hd8; const int c1 = (pass ? C_GK : C_GQ) + hh * 128 + half * 64 + a * 8; const float* gg = pass ? ggk : ggq;
      const bf16x8 x1 = ld8(pr + c1), x2 = ld8(pr + c1 + 32); float u[8], v[8]; float ss = 0.f;
#pragma unroll
      for (int i = 0; i < 8; ++i) { u[i] = bf2f((bf16_t)x1[i]); v[i] = bf2f((bf16_t)x2[i]); ss += u[i] * u[i] + v[i] * v[i]; }
      ss += shx(ss, 1, lane); ss += shx(ss, 2, lane); ss += shx(ss, 4, lane);
      const float rn = rsqrtf(ss * (1.f / 128.f) + 1e-6f);
      const f32x4 ga0 = *(const f32x4*)(gg + half * 64 + a * 8), ga1 = *(const f32x4*)(gg + half * 64 + a * 8 + 4), gb0 = *(const f32x4*)(gg + half * 64 + a * 8 + 32), gb1 = *(const f32x4*)(gg + half * 64 + a * 8 + 36);
      float o1[8], o2[8];
#pragma unroll
      for (int i = 0; i < 8; ++i) { const float y1 = u[i] * rn * (i < 4 ? ga0[i & 3] : ga1[i & 3]), y2 = v[i] * rn * (i < 4 ? gb0[i & 3] : gb1[i & 3]); o1[i] = y1 * cs[i] - y2 * sn[i]; o2[i] = y2 * cs[i] + y1 * sn[i]; }
      if (!pass) {
#pragma unroll
        for (int i = 0; i < 8; ++i) { o1[i] *= 0.12751743074602467f; o2[i] *= 0.12751743074602467f; } }
      if (!pass || lane < 16) { st8(pr + c1, o1); st8(pr + c1 + 32, o2); } }
    { const int which = lane >> 5, a32 = lane & 31; bf16_t* cp_ = pr + (which ? C_CKV : C_CQ) + a32 * 8; const float* gg = (which ? gkv : gq) + a32 * 8;
      const bf16x8 x = ld8(cp_); float u[8]; float ss = 0.f;
#pragma unroll
      for (int i = 0; i < 8; ++i) { u[i] = bf2f((bf16_t)x[i]); ss += u[i] * u[i]; }
      ss += shx(ss, 1, lane); ss += shx(ss, 2, lane); ss += shx(ss, 4, lane); ss += shx(ss, 8, lane); ss += shx(ss, 16, lane);
      const float rn = rsqrtf(ss * (1.f / 256.f) + 1e-6f); const f32x4 g0 = *(const f32x4*)gg, g1 = *(const f32x4*)(gg + 4);
      float o[8];
#pragma unroll
      for (int i = 0; i < 8; ++i) o[i] = u[i] * rn * (i < 4 ? g0[i & 3] : g1[i & 3]);
      st8(cp_, o); }
    if (lat && lane < 16) { const int pi = lane, hh = pi >> 3, jj = pi & 7, c1 = C_KR + hh * 16 + jj, c2 = c1 + 8; const int ps = hh ? cp : rp;
      const float c_ = T32[(ps * 8 + jj) * 2], s_ = T32[(ps * 8 + jj) * 2 + 1]; const float x1 = bf2f(pr[c1]), x2 = bf2f(pr[c2]);
      pr[c1] = f2bf(x1 * c_ - x2 * s_); pr[c2] = f2bf(x2 * c_ + x1 * s_); }
  }
}

DI void mla_norms(const bf16_t* __restrict__ MQ, const bf16_t* __restrict__ MKV, const bf16_t* __restrict__ PM, unsigned* __restrict__ mx) {
  const int tid_ = otid(); const int wid = tid_ >> 6, lane = tid_ & 63; const int h = lane >> 3, j8 = lane & 7;
  float qm = 0.f, km = 0.f;
  for (int row = blockIdx.x * 8 + wid; row < MR; row += gridDim.x * 8) {
    const u32x2* qp = (const u32x2*)(MQ + (long)row * 768 + lane * 12); float ss = 0.f;
#pragma unroll
    for (int i = 0; i < 3; ++i) { const u32x2 v = qp[i]; const float a = __uint_as_float(v[0] << 16), b = __uint_as_float(v[0] & 0xffff0000u), c = __uint_as_float(v[1] << 16), d = __uint_as_float(v[1] & 0xffff0000u); ss += a * a + b * b + c * c + d * d; }
    ss += shx(ss, 1, lane); ss += shx(ss, 2, lane); ss += shx(ss, 4, lane);
    qm = fmaxf(qm, ss);
    const bf16x8 kv = ld8(MKV + (long)row * 1536 + h * 192 + j8 * 8); float sk = 0.f;
#pragma unroll
    for (int i = 0; i < 8; ++i) { const float a = bf2f((bf16_t)kv[i]); sk += a * a; }
    sk += shx(sk, 1, lane); sk += shx(sk, 2, lane); sk += shx(sk, 4, lane);
    float sr = bf2f(PM[(long)row * PW + C_KR + (lane & 31)]); sr *= sr;
    sr += shx(sr, 1, lane); sr += shx(sr, 2, lane); sr += shx(sr, 4, lane); sr += shx(sr, 8, lane); sr += shx(sr, 16, lane);
    km = fmaxf(km, sk + sr);
  }
  if (j8 == 0) { atomicMax(mx + h, __float_as_uint(qm)); atomicMax(mx + 8 + h, __float_as_uint(km)); }
}

DI void mq_rope(bf16_t* __restrict__ MQ, const float* __restrict__ T32) {
  const int tid_ = otid(); const int wid = tid_ >> 6, lane = tid_ & 63;
  for (int row = CTXN + blockIdx.x * 8 + wid; row < MR; row += gridDim.x * 8) {
    const int t = row - CTXN, rp = t >> 6, cp = t & 63; bf16_t* pr = MQ + (long)row * 768;
#pragma unroll
    for (int i = 0; i < 2; ++i) { const int pp = lane + 64 * i, h = pp >> 4, pi = pp & 15, hh = pi >> 3, jj = pi & 7; const int c1 = h * 96 + 64 + hh * 16 + jj, c2 = c1 + 8; const int ps = hh ? cp : rp;
      const float c_ = T32[(ps * 8 + jj) * 2], s_ = T32[(ps * 8 + jj) * 2 + 1]; const float x1 = bf2f(pr[c1]), x2 = bf2f(pr[c2]);
      pr[c1] = f2bf(x1 * c_ - x2 * s_); pr[c2] = f2bf(x2 * c_ + x1 * s_); }
  }
}

DI void phase0(const Params& p) {
  unsigned char* ws = p.ws; const int tid = otid(); const long gt = (long)blockIdx.x * 512 + tid, gn = (long)gridDim.x * 512;
  { f32x4* X4 = (f32x4*)(ws + O_X); const f32x4* c4 = (const f32x4*)p.ctx; const f32x4* x4 = (const f32x4*)p.x;
    for (long i = gt; i < (long)MR * 256; i += gn) X4[i] = i < 65536 ? c4[i] : x4[i - 65536]; }
  { float* T128 = (float*)(ws + O_T128); float* T32 = (float*)(ws + O_T32);
    for (long i = gt; i < 256 * 32 + 256 * 8; i += gn) { int pos, jj; float inv; float* dst;
      if (i < 256 * 32) { pos = (int)i >> 5; jj = (int)i & 31; inv = powf(10000.f, -(float)jj / 32.f); dst = T128 + i * 2; }
      else { const int q = (int)i - 256 * 32; pos = q >> 3; jj = q & 7; inv = powf(10000.f, -(float)jj / 8.f); dst = T32 + (long)q * 2; }
      const float ang = (float)pos * inv; const float k = rintf(ang * 0.15915494309189535f);
      float r = fmaf(-k, 6.28318548202514648f, ang); r = fmaf(-k, -1.74845553e-07f, r);
      dst[0] = cosf(r); dst[1] = sinf(r); } }
  { float* sl = (float*)smem; float* red = sl + 2048; float* mods = (float*)(ws + O_MODS);
    for (int item = blockIdx.x; item < DEPTH * 48; item += gridDim.x) { const int l = item / 48, cg0 = (item % 48) * 128;
      __syncthreads();
      for (int k = tid; k < 1024; k += 512) { const float a = p.c[k], b = p.c_ctx[k]; sl[k] = a * sigm(a); sl[1024 + k] = b * sigm(b); }
      __syncthreads();
      const int col = tid & 127, ks = tid >> 7; const float* w = p.w_mod + ((size_t)l * 1024 + ks * 256) * 6144 + cg0 + col;
      float a0 = 0.f, a1 = 0.f;
#pragma unroll 8
      for (int k = 0; k < 256; ++k) { const float wv = w[(size_t)k * 6144]; a0 = fmaf(sl[ks * 256 + k], wv, a0); a1 = fmaf(sl[1024 + ks * 256 + k], wv, a1); }
      red[(ks * 128 + col) * 2] = a0; red[(ks * 128 + col) * 2 + 1] = a1;
      __syncthreads();
      if (tid < 256) { const int cc = tid & 127, which = tid >> 7; float s = 0.f;
        for (int q = 0; q < 4; ++q) s += red[(q * 128 + cc) * 2 + which];
        mods[((size_t)l * 2 + which) * 6144 + cg0 + cc] = s + p.b_mod[(size_t)l * 6144 + cg0 + cc]; } } }
}

DI void final_norm(const float* __restrict__ X, const float* __restrict__ g, float* __restrict__ out) {
  const int tid_ = otid(); const int wid = tid_ >> 6, lane = tid_ & 63;
  for (int t = blockIdx.x * 8 + wid; t < SEQL; t += gridDim.x * 8) {
    const float* xr = X + (long)(CTXN + t) * 1024; f32x4 v[4]; float ss = 0.f;
#pragma unroll
    for (int i = 0; i < 4; ++i) { v[i] = *(const f32x4*)(xr + i * 256 + lane * 4); ss += v[i][0] * v[i][0] + v[i][1] * v[i][1] + v[i][2] * v[i][2] + v[i][3] * v[i][3]; }
    ss = wsum(ss, lane); const float rn = rsqrtf(ss * (1.f / 1024.f) + 1e-6f);
#pragma unroll
    for (int i = 0; i < 4; ++i) { const int c = i * 256 + lane * 4; const f32x4 gg = *(const f32x4*)(g + c); *(f32x4*)(out + (long)t * 1024 + c) = v[i] * rn * gg; }
  }
}


#define XB_TMO      128
#define XB_XCNT(j)  (256  + 64 * (j))
#define XB_XSUB(j)  (1280 + 64 * (j))
#define XB_XGEN(j)  (2304 + 64 * (j))
#define XB_TOP      3328
#define XB_TOPGEN   3392
#define XCD_BAR_WORDS 3456
#define XB_SPIN_CAP (1u << 20)
DI unsigned xb_ld(unsigned* p)              { return __hip_atomic_load(p, __ATOMIC_RELAXED, __HIP_MEMORY_SCOPE_AGENT); }
DI unsigned xb_add(unsigned* p, unsigned v) { return __hip_atomic_fetch_add(p, v, __ATOMIC_RELAXED, __HIP_MEMORY_SCOPE_AGENT); }
DI unsigned xb_xcc_id() { return (unsigned)__builtin_amdgcn_s_getreg((3 << 11) | 20) & 0xFu; }
#define XB_SPIN(cond, bar) do { unsigned _sp = 0; while (cond) { __builtin_amdgcn_s_sleep(1); \
    if ((++_sp & 255u) == 0u) { if (xb_ld(&(bar)[XB_TMO])) break; if (_sp > XB_SPIN_CAP) { __hip_atomic_store(&(bar)[XB_TMO], 1u, __ATOMIC_RELAXED, __HIP_MEMORY_SCOPE_AGENT); break; } } } } while (0)
DI void xcd_barrier(unsigned* bar, const unsigned x, const unsigned nloc, const unsigned nx, const unsigned k) {
  asm volatile("s_waitcnt vmcnt(0)" ::: "memory");
  __syncthreads();
  if (threadIdx.x == 0) {
    __builtin_amdgcn_s_waitcnt(0);
    const unsigned old = xb_add(&bar[XB_XSUB(x)], 1u);
    const unsigned gen = k;
    if (old + 1u == (k + 1u) * nloc) {
      __builtin_amdgcn_fence(__ATOMIC_RELEASE, "agent");
      asm volatile("s_waitcnt vmcnt(0)" ::: "memory");
      const unsigned og = xb_add(&bar[XB_TOP], 1u);
      const unsigned tg = k;
      if (og + 1u == (k + 1u) * nx) xb_add(&bar[XB_TOPGEN], 1u);
      else XB_SPIN(xb_ld(&bar[XB_TOPGEN]) == tg, bar);
      __builtin_amdgcn_fence(__ATOMIC_ACQUIRE, "agent");
      xb_add(&bar[XB_XGEN(x)], 1u);
      asm volatile("s_waitcnt vmcnt(0)" ::: "memory");
    } else {
      XB_SPIN(xb_ld(&bar[XB_XGEN(x)]) == gen, bar);
      __builtin_amdgcn_fence(__ATOMIC_ACQUIRE, "agent");
      asm volatile("s_waitcnt vmcnt(0)" ::: "memory");
    }
  }
  __syncthreads();
}

#define WSP(T, off) ((T*)(ws + (off)))
#define PHASE_BEGIN const Params& p = kargs(); unsigned char* ws = p.ws;
__global__ void __launch_bounds__(512) mega(Params p_unused) {
  cg::grid_group grid = cg::this_grid();
#ifdef PROBE_T
  unsigned tacc[16]; for (int i = 0; i < 16; ++i) tacc[i] = 0u; unsigned long long tprev = __builtin_amdgcn_s_memrealtime();
#define TICK(k) do { const unsigned long long now_ = __builtin_amdgcn_s_memrealtime(); tacc[k] += (unsigned)(now_ - tprev); tprev = now_; } while (0)
#else
#define TICK(k) do {} while (0)
#endif
  constexpr int NM = MR / 256;
  const float LOG2E = 1.4426950408889634f;
  const float mlaC = 0.10206207261596577f * LOG2E, mlaT = 8.f / 0.10206207261596577f, gqaC = 0.08838834764831845f * LOG2E, gqaT = 8.f / 0.08838834764831845f;

  { const Params& p = kargs(); if (blockIdx.x == 0) { unsigned* bar = (unsigned*)(p.ws + O_BAR); for (int i = threadIdx.x; i < XCD_BAR_WORDS; i += 512) bar[i] = 0u; } }
  { const Params& p = kargs(); phase0(p); }
  { const Params& p = kargs(); conv_layer(p, 0); }
  grid.sync(); TICK(0);
  const unsigned xb_x = __builtin_amdgcn_readfirstlane(xb_xcc_id());
  { unsigned* bar = (unsigned*)(kargs().ws + O_BAR); if (threadIdx.x == 0) (void)xb_add(&bar[XB_XCNT(xb_x)], 1u); }
  grid.sync();
  unsigned xb_pack;
  { unsigned* bar = (unsigned*)(kargs().ws + O_BAR); unsigned nloc = 1u, nx = 0u;
#pragma unroll
    for (unsigned j = 0; j < 16; ++j) { const unsigned c = xb_ld(&bar[XB_XCNT(j)]); nx += (c > 0u) ? 1u : 0u; nloc = (j == xb_x) ? c : nloc; }
    nloc = nloc > 0u ? nloc : 1u; nx = nx > 0u ? nx : 1u;
    xb_pack = __builtin_amdgcn_readfirstlane(xb_x | (nloc << 8) | (nx << 16)); }
#define GSYNC(idx) do { const unsigned pk_ = __builtin_amdgcn_readfirstlane(xb_pack); xcd_barrier((unsigned*)(kargs().ws + O_BAR), pk_ & 255u, (pk_ >> 8) & 255u, pk_ >> 16, (unsigned)(l * 13 + (idx))); } while (0)
#pragma unroll 1
  for (int l = 0; l < DEPTH; ++l) {
    const bool need_ctx = l < DEPTH - 1;
    { PHASE_BEGIN
    if (l > 0) conv_layer(kargs(), l);
    norm_mod(WSP(float, O_X), WSP(bf16_t, O_H), p.g_mix + l * 1024, WSP(float, O_MODS) + (size_t)l * 2 * 6144, 0, 1);
    }
    GSYNC(0); TICK(1);
    { PHASE_BEGIN
    gemm_phase<false>(WSP(bf16_t, O_H), 1024, WSP(bf16_t, O_WIN), 1024, 1024, NM, PW / 256, EpiStore{WSP(bf16_t, O_PM), PW, 0});
    }
    GSYNC(1); TICK(2);
    { PHASE_BEGIN
    if (blockIdx.x == 0 && threadIdx.x < 16) ((unsigned*)(ws + O_BAR))[3900 + threadIdx.x] = 0u;
    feat_pass(WSP(bf16_t, O_PM), WSP(float, O_T128), WSP(float, O_T32), p.g_mla_q + l * 256, p.g_mla_kv + l * 256, p.g_gqa_q + l * 128, p.g_gqa_k + l * 128);
    }
    GSYNC(2); TICK(3);
    { PHASE_BEGIN
    gemm_phase<false>(WSP(bf16_t, O_PM) + C_CQ, PW, WSP(bf16_t, O_QB), 256, 256, NM, 3, EpiStore{WSP(bf16_t, O_MQ), 768, 0});
    gemm_phase<false>(WSP(bf16_t, O_PM) + C_CKV, PW, WSP(bf16_t, O_KVB), 256, 256, NM, 6, EpiStore{WSP(bf16_t, O_MKV), 1536, 0});
#pragma unroll 1
    for (int it = blockIdx.x; it < NCH * 4; it += gridDim.x) ret_u_item(it >> 2, it & 3, WSP(bf16_t, O_PM), WSP(bf16_t, O_S), p.lg2[it & 3], p.lg2[4 + (it & 3)]);
    }
    GSYNC(3); TICK(4);
    { PHASE_BEGIN
    mla_norms(WSP(bf16_t, O_MQ), WSP(bf16_t, O_MKV), WSP(bf16_t, O_PM), (unsigned*)(ws + O_BAR) + 3900);
    mq_rope(WSP(bf16_t, O_MQ), WSP(float, O_T32));
    ret_scan(WSP(bf16_t, O_S), p.lg2);
    }
    GSYNC(4); TICK(5);
    { PHASE_BEGIN
    { bf16_t* PM = WSP(bf16_t, O_PM);
      float gq_bound; { const int ln = otid() & 63; const float* gq_ = p.g_gqa_q + l * 128; const float* gk_ = p.g_gqa_k + l * 128;
        float mq = fmaxf(fabsf(gq_[ln]), fabsf(gq_[ln + 64])), mk = fmaxf(fabsf(gk_[ln]), fabsf(gk_[ln + 64]));
#pragma unroll
        for (int o_ = 32; o_ > 0; o_ >>= 1) { mq = fmaxf(mq, shx(mq, o_, ln)); mk = fmaxf(mk, shx(mk, o_, ln)); }
        gq_bound = __builtin_amdgcn_readfirstlane(__float_as_uint(16.322293f * mq * mk)) ? __uint_as_float(__builtin_amdgcn_readfirstlane(__float_as_uint(16.322293f * mq * mk))) : 0.f; }
      const bool gq_fixed = gq_bound < 56.f;
      const int nlat = 512, nctx = need_ctx ? 8 : 0;
#pragma unroll 1
      for (int it = blockIdx.x; it < nlat + nctx; it += gridDim.x) { const int hd = it & 7, qb = it >> 3; const bool isc = it >= nlat;
        const long q0 = (isc ? 0 : (long)(CTXN + qb * 256) * PW) + C_GQ + hd * 128;
        if (gq_fixed) attn_item<8, 1>(PM + q0, PW, PM + C_GK + (hd >> 2) * 128, PW, PM, 0, PM + C_GV + (hd >> 2) * 128, PW, PM + q0, PW, isc ? CTXN : MR, 1.f, 11.541560327111707f, -gq_bound);
        else          attn_item<8, 0>(PM + q0, PW, PM + C_GK + (hd >> 2) * 128, PW, PM, 0, PM + C_GV + (hd >> 2) * 128, PW, PM + q0, PW, isc ? CTXN : MR, 1.f, 11.541560327111707f); }
      const int n0 = need_ctx ? 0 : 2;
#pragma unroll 1
      for (int it = blockIdx.x; it < (NCH - n0) * 4; it += gridDim.x) { const int n = n0 + (it >> 2), h = it & 3; ret_out_item(n, h, PM, WSP(bf16_t, O_S), p.lg2[h], p.lg2[4 + h]); } }
    }
    GSYNC(5); TICK(6);
    { PHASE_BEGIN
    { bf16_t* PM = WSP(bf16_t, O_PM); const bf16_t* MQ = WSP(bf16_t, O_MQ); const bf16_t* MKV = WSP(bf16_t, O_MKV);
#pragma unroll 1
      for (int it = blockIdx.x; it < 512 + (need_ctx ? 8 : 0); it += gridDim.x) {
        const int hd = it & 7; const bool isc = it >= 512; const int qb = it >> 3; const long rq = isc ? 0 : (long)(CTXN + qb * 256);
        const unsigned* mx = (const unsigned*)(ws + O_BAR) + 3900;
        const float bnd = __uint_as_float(__builtin_amdgcn_readfirstlane(__float_as_uint(1.002f * sqrtf(__uint_as_float(xb_ld((unsigned*)mx + hd)) * __uint_as_float(xb_ld((unsigned*)mx + 8 + hd))))));
        if (bnd < 56.f) attn_item<6, 1>(MQ + rq * 768 + hd * 96, 768, MKV + hd * 192, 1536, PM + C_KR, PW, MKV + hd * 192 + 64, 1536, PM + rq * PW + C_RQ + hd * 128, PW, isc ? CTXN : MR, 1.f, 11.541560327111707f, -bnd);
        else            attn_item<6, 0>(MQ + rq * 768 + hd * 96, 768, MKV + hd * 192, 1536, PM + C_KR, PW, MKV + hd * 192 + 64, 1536, PM + rq * PW + C_RQ + hd * 128, PW, isc ? CTXN : MR, 1.f, 11.541560327111707f); } }
    }
    GSYNC(6); TICK(7);
    { PHASE_BEGIN
    gemm_phase<false>(WSP(bf16_t, O_H), 1024, WSP(bf16_t, O_WIN) + (size_t)GATE_ROW0 * 1024, 1024, 1024, NM - 1, 12, EpiStore{WSP(bf16_t, O_GATES), 3072, 1}, 1);
    if (need_ctx) { const int tid = otid(); bf16_t* G = WSP(bf16_t, O_GATES);
#pragma unroll 1
      for (int it = blockIdx.x; it < 8 * 96; it += gridDim.x) { const int rt = it / 96, ct = it - rt * 96; float o[2];
        ctx_tile(WSP(bf16_t, O_H), 1024, WSP(bf16_t, O_WIN) + (size_t)GATE_ROW0 * 1024, 1024, 1024, rt * 32, ct * 32, o);
#pragma unroll
        for (int s = 0; s < 2; ++s) { const int e = tid + 512 * s; G[(long)(rt * 32 + (e >> 5)) * 3072 + ct * 32 + perm32(e & 31)] = f2bf(sigm(o[s])); } } }
    }
    GSYNC(7); TICK(8);
    { PHASE_BEGIN
    gemm_phase<true>(WSP(bf16_t, O_PM), PW, WSP(bf16_t, O_RO), 1024, 1024, NM - 1, 4, EpiMerge{WSP(bf16_t, O_GATES), WSP(bf16_t, O_PM) + C_RV, PW}, 1);
    if (need_ctx) { const int tid = otid(); bf16_t* PM = WSP(bf16_t, O_PM); const bf16_t* G = WSP(bf16_t, O_GATES);
#pragma unroll 1
      for (int it = blockIdx.x; it < 8 * 32; it += gridDim.x) { const int rt = it >> 5, ct = it & 31; float z[2] = {0.f, 0.f};
#pragma unroll 1
        for (int b = 0; b < 3; ++b) { float o[2];
          ctx_tile(PM + (b == 0 ? C_RG : (b == 1 ? C_RQ : C_GQ)), PW, WSP(bf16_t, O_RO) + (size_t)b * 1024 * 1024, 1024, 1024, rt * 32, ct * 32, o);
#pragma unroll
          for (int s = 0; s < 2; ++s) { const int e = tid + 512 * s; z[s] += o[s] * bf2f(G[(long)(rt * 32 + (e >> 5)) * 3072 + b * 1024 + ct * 32 + perm32(e & 31)]); } }
#pragma unroll
        for (int s = 0; s < 2; ++s) { const int e = tid + 512 * s; PM[(long)(rt * 32 + (e >> 5)) * PW + C_RV + ct * 32 + perm32(e & 31)] = f2bf(z[s]); } } }
    }
    GSYNC(8); TICK(9);
    { PHASE_BEGIN
    gemm_phase<false>(WSP(bf16_t, O_PM) + C_RV, PW, WSP(bf16_t, O_WO), 1024, 1024, NM - 1, 4, EpiResid{WSP(float, O_X), WSP(float, O_MODS) + (size_t)l * 2 * 6144, 2}, 1);
    if (need_ctx) { const int tid = otid(); float* X = WSP(float, O_X); const float* mv = WSP(float, O_MODS) + (size_t)l * 2 * 6144 + 6144 + 2 * 1024;
#pragma unroll 1
      for (int it = blockIdx.x; it < 8 * 32; it += gridDim.x) { const int rt = it >> 5, ct = it & 31; float o[2];
        ctx_tile(WSP(bf16_t, O_PM) + C_RV, PW, WSP(bf16_t, O_WO), 1024, 1024, rt * 32, ct * 32, o);
#pragma unroll
        for (int s = 0; s < 2; ++s) { const int e = tid + 512 * s; const int col = ct * 32 + perm32(e & 31); X[(long)(rt * 32 + (e >> 5)) * 1024 + col] += mv[col] * o[s]; } } }
    }
    GSYNC(9); TICK(10);
    { PHASE_BEGIN
    norm_mod(WSP(float, O_X), WSP(bf16_t, O_H), p.g_ffn + l * 1024, WSP(float, O_MODS) + (size_t)l * 2 * 6144, 3, 4);
    }
    GSYNC(10); TICK(11);
    { PHASE_BEGIN
    gemm_phase<false>(WSP(bf16_t, O_H), 1024, WSP(bf16_t, O_FI), 1024, 1024, NM, 22, EpiSwiglu{WSP(bf16_t, O_ACT)});
    }
    GSYNC(11); TICK(12);
    { PHASE_BEGIN
    gemm_phase<false>(WSP(bf16_t, O_ACT), FH, WSP(bf16_t, O_FO), FH, FH, NM - 1, 4, EpiResid{WSP(float, O_X), WSP(float, O_MODS) + (size_t)l * 2 * 6144, 5}, 1);
    if (need_ctx) { const int tid = otid(); float* X = WSP(float, O_X); const float* mv = WSP(float, O_MODS) + (size_t)l * 2 * 6144 + 6144 + 5 * 1024;
#pragma unroll 1
      for (int it = blockIdx.x; it < 8 * 32; it += gridDim.x) { const int rt = it >> 5, ct = it & 31; float o[2];
        ctx_tile(WSP(bf16_t, O_ACT), FH, WSP(bf16_t, O_FO), FH, FH, rt * 32, ct * 32, o);
#pragma unroll
        for (int s = 0; s < 2; ++s) { const int e = tid + 512 * s; const int col = ct * 32 + perm32(e & 31); X[(long)(rt * 32 + (e >> 5)) * 1024 + col] += mv[col] * o[s]; } } }
    }
    GSYNC(12); TICK(13);
  }
  { PHASE_BEGIN final_norm(WSP(float, O_X), p.g_final, p.out); }
#ifdef PROBE_T
  if (blockIdx.x == 0) { const int ia[] = {PROBE_A}; unsigned a = 0; for (unsigned q = 0; q < sizeof(ia) / 4; ++q) a += tacc[ia[q]];
    const unsigned long long t0 = __builtin_amdgcn_s_memrealtime(); while (__builtin_amdgcn_s_memrealtime() - t0 < 4ull * a) __builtin_amdgcn_s_sleep(8); }
#endif
}

extern "C" void kernel_launch(void* const* d_in, const int* in_sizes, int n_in, void* d_out, int out_size, void* d_ws, size_t ws_size, hipStream_t stream) {
  static int grid_blocks = 0;
  if (grid_blocks == 0) {
    if (n_in != 22 || ws_size < WS_END || out_size != SEQL * DM) { fprintf(stderr, "kernel_launch: unexpected shapes n_in %d ws %zu (need %zu) out %d\n", n_in, ws_size, (size_t)WS_END, out_size); grid_blocks = -1; return; }
    int dev = 0, cus = 0, per_cu = 0;
    hipGetDevice(&dev); hipDeviceGetAttribute(&cus, hipDeviceAttributeMultiprocessorCount, dev);
    if (hipFuncSetAttribute((const void*)mega, hipFuncAttributeMaxDynamicSharedMemorySize, LDS_BYTES) != hipSuccess) { fprintf(stderr, "kernel_launch: hipFuncSetAttribute failed\n"); grid_blocks = -1; return; }
    if (hipOccupancyMaxActiveBlocksPerMultiprocessor(&per_cu, (const void*)mega, 512, LDS_BYTES) != hipSuccess || per_cu < 1) { fprintf(stderr, "kernel_launch: occupancy query failed (%d)\n", per_cu); per_cu = 1; (void)hipGetLastError(); }
    grid_blocks = cus * 1;
  }
  if (grid_blocks < 0) return;
  Params p{};
  const float** pp = (const float**)&p;
  for (int i = 0; i < 22; ++i) pp[i] = (const float*)d_in[i];
  p.out = (float*)d_out; p.ws = (unsigned char*)d_ws;
  for (int h = 0; h < 4; ++h) { p.lg2[h] = (float)(log1p(-exp2(-5.0 - h)) / log(2.0)); p.lg2[4 + h] = (float)(log1p(-exp2(-5.5 - h)) / log(2.0)); }
  void* args[] = {&p};
  hipError_t e = hipLaunchCooperativeKernel((const void*)mega, dim3(grid_blocks), dim3(512), args, LDS_BYTES, stream);
  if (e != hipSuccess) fprintf(stderr, "cooperative launch failed: %s (grid %d)\n", hipGetErrorString(e), grid_blocks);
}
```
